# Optimizing an MI355X kernel written in HIP

```python
import math
import jax, jax.numpy as jnp
from jax import lax
import numpy as np


D_MODEL = 1024
BATCH = 4
SEQ = 4096
DEPTH = 4
DEC_BATCH = 128
DEC_SEQ = 8
PAST_LEN = 8192
PAGE_SIZE = 128

N_A = DEPTH // 2
N_B = DEPTH - N_A
D_RNN = D_MODEL
LRU_BW = 256
LRU_BLOCKS = D_RNN // LRU_BW
CONV_W = 4
LRU_C = 8.0
HEAD_DIM = 64
N_HEADS = D_MODEL // HEAD_DIM
N_KV = max(1, N_HEADS // 8)
GROUP = N_HEADS // N_KV
WINDOW = 128
D_FF = ((8 * D_MODEL // 3 + 127) // 128) * 128
EPS = 1e-6
NEG = -1e30

kernel_name = 'yoco_hawk_swa_sink_alibi_decoder'


def rms_norm(x, g):
    xf = x.astype(jnp.float32)
    y = xf * lax.rsqrt(jnp.mean(xf * xf, axis=-1, keepdims=True) + EPS)
    return (y * g.astype(jnp.float32)).astype(x.dtype)


def swiglu(x, w_gu, w_down):
    gu = x @ w_gu
    return (jax.nn.silu(gu[..., :D_FF]) * gu[..., D_FF:]) @ w_down


def alibi_slopes():
    return jnp.exp2(-8.0 * jnp.arange(1, N_HEADS + 1, dtype=jnp.float32) / N_HEADS)


def causal_conv(x, prefix, w, b):
    xe = jnp.concatenate([prefix.astype(x.dtype), x], axis=1)
    t = x.shape[1]
    y = b + sum(xe[:, k:k + t] * w[k] for k in range(CONV_W))
    return y, xe[:, xe.shape[1] - (CONV_W - 1):]


def block_diag(x, w, b):
    xb = x.reshape(x.shape[:-1] + (LRU_BLOCKS, LRU_BW))
    y = jnp.einsum('btnc,ncd->btnd', xb, w.astype(jnp.float32))
    return y.reshape(x.shape) + b.astype(jnp.float32)


def rg_lru(x, h0, w_a, b_a, w_x, b_x, lam):
    xf = x.astype(jnp.float32)
    r = jax.nn.sigmoid(block_diag(xf, w_a, b_a))
    i = jax.nn.sigmoid(block_diag(xf, w_x, b_x))
    log_a = -LRU_C * r * jax.nn.softplus(-lam.astype(jnp.float32))
    a = jnp.exp(log_a)
    u = jnp.sqrt(-jnp.expm1(2.0 * log_a)) * (i * xf)
    u = u.at[:, 0].add(a[:, 0] * h0.astype(jnp.float32))

    def combine(left, right):
        al, bl = left
        ar, br = right
        return al * ar, ar * bl + br

    _, h = lax.associative_scan(combine, (a, u), axis=1)
    return h, h[:, -1]


def recurrent_block(x, h0, buf0, w_in, conv_w, conv_b, w_a, b_a, w_x, b_x, lam, w_out):
    proj = x @ w_in
    gate, xr = proj[..., :D_RNN], proj[..., D_RNN:]
    xc, buf = causal_conv(xr, buf0, conv_w, conv_b)
    h, h_last = rg_lru(xc, h0, w_a, b_a, w_x, b_x, lam)
    y = (h.astype(x.dtype) * jax.nn.gelu(gate)) @ w_out
    return y, h_last.astype(x.dtype), buf


def window_attention(q, k, v, q_pos, k_pos, sinks):
    b, n, tq = q.shape[:3]
    qg = q.reshape(b, n, tq, N_KV, GROUP, HEAD_DIM)
    s = jnp.einsum('bnqkgd,bnskd->bnkgqs', qg, k).astype(jnp.float32) * (HEAD_DIM ** -0.5)
    diff = q_pos[:, :, None] - k_pos[:, None, :]
    valid = (diff >= 0) & (diff < WINDOW) & (k_pos[:, None, :] >= 0)
    slopes = alibi_slopes().reshape(N_KV, GROUP)
    bias = -slopes[None, :, :, None, None] * diff.astype(jnp.float32)[:, None, None]
    s = jnp.where(valid[:, None, None], s + bias, NEG)
    sink = sinks.astype(jnp.float32).reshape(N_KV, GROUP)[:, :, None, None]
    m = jnp.maximum(jnp.max(s, axis=-1, keepdims=True), sink)
    p = jnp.exp(s - m)
    p = p / (jnp.sum(p, axis=-1, keepdims=True) + jnp.exp(sink - m))
    o = jnp.einsum('bnkgqs,bnskd->bnqkgd', p.astype(v.dtype), v)
    return o.reshape(b, n, tq, N_HEADS * HEAD_DIM)


def prompt_window_attention(q, k, v, sinks):
    b, t = q.shape[:2]
    nb = t // WINDOW
    qb = q.reshape(b, nb, WINDOW, N_HEADS, HEAD_DIM)

    def band(z):
        zb = z.reshape(b, nb, WINDOW, N_KV, HEAD_DIM)
        prev = jnp.concatenate([jnp.zeros_like(zb[:, :1]), zb[:, :-1]], axis=1)
        return jnp.concatenate([prev, zb], axis=2)

    start = jnp.arange(nb, dtype=jnp.int32)[:, None] * WINDOW
    q_pos = start + jnp.arange(WINDOW, dtype=jnp.int32)[None]
    k_pos = start - WINDOW + jnp.arange(2 * WINDOW, dtype=jnp.int32)[None]
    o = window_attention(qb, band(k), band(v), q_pos, k_pos, sinks)
    return o.reshape(b, t, N_HEADS * HEAD_DIM)


def sample_window_attention(q, k_all, v_all, sinks):
    b, tq = q.shape[:2]
    tk = k_all.shape[1]
    q_pos = PAST_LEN + jnp.arange(tq, dtype=jnp.int32)
    k_pos = PAST_LEN + tq - tk + jnp.arange(tk, dtype=jnp.int32)
    o = window_attention(q.reshape(b, 1, tq, N_HEADS, HEAD_DIM), k_all[:, None], v_all[:, None],
                         q_pos[None], k_pos[None], sinks)
    return o.reshape(b, tq, N_HEADS * HEAD_DIM)


def trunk(x, rg_h0, rg_buf0, cache_k, cache_v, p):
    rg_h, rg_buf = [], []
    k_att = v_att = new_k = new_v = None
    for l in range(DEPTH):
        x = x + 0.5 * swiglu(rms_norm(x, p['ffn1_norm'][l]), p['ffn1_w_gu'][l], p['ffn1_w_down'][l])
        hn = rms_norm(x, p['mix_norm'][l])
        if l < N_A:
            y, hl, bl = recurrent_block(hn, rg_h0[l], rg_buf0[l], p['rg_w_in'][l], p['rg_conv_w'][l],
                                        p['rg_conv_b'][l], p['rg_w_a'][l], p['rg_b_a'][l], p['rg_w_x'][l],
                                        p['rg_b_x'][l], p['rg_lambda'][l], p['rg_w_out'][l])
            rg_h.append(hl)
            rg_buf.append(bl)
        else:
            j = l - N_A
            q = hn @ p['attn_w_q'][j]
            if cache_k is None:
                o = prompt_window_attention(q, k_att, v_att, p['attn_sinks'][j])
            else:
                o = sample_window_attention(q, k_att, v_att, p['attn_sinks'][j])
            y = o @ p['attn_w_o'][j]
        x = x + y
        x = x + 0.5 * swiglu(rms_norm(x, p['ffn2_norm'][l]), p['ffn2_w_gu'][l], p['ffn2_w_down'][l])
        if l == N_A - 1:
            b, t = x.shape[:2]
            kv = rms_norm(x, p['kv_norm']) @ p['w_kv']
            k = kv[..., :N_KV * HEAD_DIM].reshape(b, t, N_KV, HEAD_DIM)
            v = kv[..., N_KV * HEAD_DIM:].reshape(b, t, N_KV, HEAD_DIM)
            if cache_k is None:
                wb = min(WINDOW, t)
                k_att, v_att = k, v
            else:
                wb = cache_k.shape[1]
                k_att = jnp.concatenate([cache_k.astype(k.dtype), k], axis=1)
                v_att = jnp.concatenate([cache_v.astype(v.dtype), v], axis=1)
            new_k = k_att[:, k_att.shape[1] - wb:]
            new_v = v_att[:, v_att.shape[1] - wb:]
    y = rms_norm(x, p['final_norm'])
    return y, jnp.stack(rg_h), jnp.stack(rg_buf), new_k, new_v


def setup_inputs(seed: int = 0) -> dict:
    key = jax.random.key(seed)
    ks = iter(jax.random.split(key, 40))
    f32 = jnp.float32

    def nrm(shape, scale):
        return jax.random.normal(next(ks), shape, f32) * scale

    win_buf = min(WINDOW, PAST_LEN)
    a0 = jax.random.uniform(next(ks), (N_A, D_RNN), f32, 0.9, 0.999)
    s0 = a0 ** (1.0 / LRU_C)
    lam = jnp.log(s0) - jnp.log1p(-s0)
    return {
        'x_prompt': nrm((BATCH, SEQ, D_MODEL), 1.0),
        'x_sample': nrm((DEC_BATCH, DEC_SEQ, D_MODEL), 1.0),
        'state_rg_h': nrm((N_A, DEC_BATCH, D_RNN), 0.5),
        'state_rg_conv': nrm((N_A, DEC_BATCH, CONV_W - 1, D_RNN), 1.0),
        'cache_k': nrm((DEC_BATCH, win_buf, N_KV, HEAD_DIM), 1.0),
        'cache_v': nrm((DEC_BATCH, win_buf, N_KV, HEAD_DIM), 1.0),
        'ffn1_norm': 1.0 + nrm((DEPTH, D_MODEL), 0.01),
        'ffn1_w_gu': nrm((DEPTH, D_MODEL, 2 * D_FF), D_MODEL ** -0.5),
        'ffn1_w_down': nrm((DEPTH, D_FF, D_MODEL), D_FF ** -0.5),
        'mix_norm': 1.0 + nrm((DEPTH, D_MODEL), 0.01),
        'ffn2_norm': 1.0 + nrm((DEPTH, D_MODEL), 0.01),
        'ffn2_w_gu': nrm((DEPTH, D_MODEL, 2 * D_FF), D_MODEL ** -0.5),
        'ffn2_w_down': nrm((DEPTH, D_FF, D_MODEL), D_FF ** -0.5),
        'rg_w_in': nrm((N_A, D_MODEL, 2 * D_RNN), D_MODEL ** -0.5),
        'rg_conv_w': nrm((N_A, CONV_W, D_RNN), CONV_W ** -0.5),
        'rg_conv_b': nrm((N_A, D_RNN), 0.01),
        'rg_w_a': nrm((N_A, LRU_BLOCKS, LRU_BW, LRU_BW), LRU_BW ** -0.5),
        'rg_b_a': nrm((N_A, D_RNN), 0.01),
        'rg_w_x': nrm((N_A, LRU_BLOCKS, LRU_BW, LRU_BW), LRU_BW ** -0.5),
        'rg_b_x': nrm((N_A, D_RNN), 0.01),
        'rg_lambda': lam,
        'rg_w_out': nrm((N_A, D_RNN, D_MODEL), D_RNN ** -0.5),
        'kv_norm': 1.0 + nrm((D_MODEL,), 0.01),
        'w_kv': nrm((D_MODEL, 2 * N_KV * HEAD_DIM), D_MODEL ** -0.5),
        'attn_w_q': nrm((N_B, D_MODEL, N_HEADS * HEAD_DIM), D_MODEL ** -0.5),
        'attn_sinks': nrm((N_B, N_HEADS), 1.0),
        'attn_w_o': nrm((N_B, N_HEADS * HEAD_DIM, D_MODEL), (N_HEADS * HEAD_DIM) ** -0.5),
        'final_norm': 1.0 + nrm((D_MODEL,), 0.01),
    }


def reference(x_prompt, x_sample, state_rg_h, state_rg_conv, cache_k, cache_v,
              ffn1_norm, ffn1_w_gu, ffn1_w_down, mix_norm, ffn2_norm, ffn2_w_gu, ffn2_w_down,
              rg_w_in, rg_conv_w, rg_conv_b, rg_w_a, rg_b_a, rg_w_x, rg_b_x, rg_lambda, rg_w_out,
              kv_norm, w_kv, attn_w_q, attn_sinks, attn_w_o, final_norm):
    p = dict(ffn1_norm=ffn1_norm, ffn1_w_gu=ffn1_w_gu, ffn1_w_down=ffn1_w_down, mix_norm=mix_norm,
             ffn2_norm=ffn2_norm, ffn2_w_gu=ffn2_w_gu, ffn2_w_down=ffn2_w_down,
             rg_w_in=rg_w_in, rg_conv_w=rg_conv_w, rg_conv_b=rg_conv_b, rg_w_a=rg_w_a, rg_b_a=rg_b_a,
             rg_w_x=rg_w_x, rg_b_x=rg_b_x, rg_lambda=rg_lambda, rg_w_out=rg_w_out,
             kv_norm=kv_norm, w_kv=w_kv, attn_w_q=attn_w_q, attn_sinks=attn_sinks, attn_w_o=attn_w_o,
             final_norm=final_norm)
    b = x_prompt.shape[0]
    h0 = jnp.zeros((N_A, b, D_RNN), x_prompt.dtype)
    buf0 = jnp.zeros((N_A, b, CONV_W - 1, D_RNN), x_prompt.dtype)
    y_prompt, p_h, p_conv, p_k, p_v = trunk(x_prompt, h0, buf0, None, None, p)
    y_sample, s_h, s_conv, s_k, s_v = trunk(x_sample, state_rg_h, state_rg_conv, cache_k, cache_v, p)
    return (y_prompt, y_sample, p_h, p_conv, p_k, p_v, s_h, s_conv, s_k, s_v)
```

```cpp
#include <hip/hip_runtime.h>
#include <hip/hip_cooperative_groups.h>
#include <cstdio>
#include <cstdint>
namespace cg = cooperative_groups;

#ifndef N_LAUNCH_MODE
#define N_LAUNCH_MODE 0
#endif

#define LAS __attribute__((address_space(3)))
#define GAS __attribute__((address_space(1)))
typedef unsigned short bf16_t;
typedef short bf16x8 __attribute__((ext_vector_type(8)));
typedef float f32x4 __attribute__((ext_vector_type(4)));
typedef float f32x2 __attribute__((ext_vector_type(2)));
typedef unsigned u32x4 __attribute__((ext_vector_type(4)));
typedef unsigned u32x2 __attribute__((ext_vector_type(2)));
typedef _Float16 h16x8 __attribute__((ext_vector_type(8)));
typedef _Float16 h16x2 __attribute__((ext_vector_type(2)));

constexpr int D = 1024, DFF = 2816, NGU = 5632;
constexpr int MP = 16384, MS = 1024, M = MP + MS;
constexpr int SEQ = 4096, NSEQ = 4, DB = 128, DS = 8;
constexpr int NTHR = 512;
constexpr float EPS = 1e-6f;

constexpr size_t O_X = 0;
constexpr size_t O_PH = 17825792, O_PC = O_PH + 8192, O_PK = O_PC + 24576, O_PV = O_PK + 65536;
constexpr size_t O_SH = O_PV + 65536, O_SC = O_SH + 262144, O_SK = O_SC + 786432, O_SV = O_SK + 2097152;
constexpr size_t OUT_TOTAL = O_SV + 2097152;

constexpr size_t WS_SS = 0;
constexpr size_t WS_SPT = 917504;
constexpr size_t WS_CARRY = 1048576;
constexpr size_t WS_KVB = WS_CARRY + 2097152;
constexpr size_t WS_XB = WS_KVB + (size_t)M * 256 * 2;
constexpr size_t WS_MIX = WS_XB + (size_t)M * D * 2;
constexpr size_t MIX_GG = 0;
constexpr size_t MIX_XR = (size_t)M * D * 2;
constexpr size_t MIX_U = MIX_XR + (size_t)M * D * 2;
constexpr size_t MIX_XC = MIX_XR + (size_t)M * D * 4;
constexpr size_t MIX_BYTES = MIX_XC + (size_t)M * D * 2;
constexpr size_t WS_W = WS_MIX + MIX_BYTES;
constexpr size_t W_GU = 0, W_D = W_GU + 8ull * NGU * D, W_IN = W_D + 8ull * D * DFF, W_OUT = W_IN + 2ull * 2048 * D;
constexpr size_t W_KV = W_OUT + 2ull * D * D, W_Q = W_KV + 256ull * D, W_O = W_Q + 2ull * D * D, W_G = W_O + 2ull * D * D;
constexpr size_t W_END = W_G + 2ull * 2048 * 256;
constexpr size_t WS_SSP = WS_W + W_END * 2;
constexpr size_t WS_CKB = WS_SSP + 13ull * M * 16 * 4;
constexpr size_t WS_BAR = WS_CKB + 2ull * DB * 128 * 128 * 2;
constexpr size_t WS_END = WS_BAR + 16384;

struct Params { const float* in[28]; float* out; unsigned char* ws; int lo, hi; };

__device__ __forceinline__ unsigned cvt_pk_bf16(float lo, float hi) { unsigned r; asm volatile("v_cvt_pk_bf16_f32 %0, %1, %2" : "=v"(r) : "v"(lo), "v"(hi)); return r; }
__device__ __forceinline__ void st16_wt(void* p, u32x4 v) { asm volatile("global_store_dwordx4 %0, %1, off sc1\n\ts_nop 1" :: "v"(p), "v"(v) : "memory"); }
__device__ __forceinline__ float bf_lo(unsigned w) { return __uint_as_float(w << 16); }
__device__ __forceinline__ float bf_hi(unsigned w) { return __uint_as_float(w & 0xffff0000u); }
__device__ __forceinline__ float fast_rcp(float x) { return __builtin_amdgcn_rcpf(x); }
__device__ __forceinline__ float sigmoidf_(float x) { return fast_rcp(1.f + __expf(-x)); }
__device__ __forceinline__ float silu_(float x) { return x * sigmoidf_(x); }
__device__ __forceinline__ float gelu_tanh_(float x) { return x * sigmoidf_(1.5957691216f * (x + 0.044715f * x * x * x)); }
__device__ __forceinline__ float rstd_of(const float* ssp, int row) { const GAS f32x4* p = (const GAS f32x4*)(ssp + (size_t)row * 16); const f32x4 a = p[0], b = p[1], c = p[2], d = p[3];
    const float ss = ((a.x + a.y) + (a.z + a.w)) + ((b.x + b.y) + (b.z + b.w)) + ((c.x + c.y) + (c.z + c.w)) + ((d.x + d.y) + (d.z + d.w)); return rsqrtf(ss * (1.f / D) + EPS); }
constexpr int RS_OFF = 131072 + 64;
#define GASP __attribute__((address_space(1)))
__device__ __forceinline__ void rstd_prefetch(f32x4 (&pf)[4], const float* ssp, int pm, int tid) {
    if (tid < 256) { const GASP f32x4* p = (const GASP f32x4*)(ssp + (size_t)(pm * 256 + tid) * 16); pf[0] = p[0]; pf[1] = p[1]; pf[2] = p[2]; pf[3] = p[3]; }
}
__device__ __forceinline__ void unit_rstd(const f32x4 (&pf)[4], LAS float* rsl, int tid) {
    if (tid < 256) { const f32x4 a = pf[0], b = pf[1], c = pf[2], d = pf[3];
        const float ss = ((a.x + a.y) + (a.z + a.w)) + ((b.x + b.y) + (b.z + b.w)) + ((c.x + c.y) + (c.z + c.w)) + ((d.x + d.y) + (d.z + d.w)); rsl[tid] = rsqrtf(ss * (1.f / D) + EPS); }
    asm volatile("s_waitcnt lgkmcnt(0)" ::: "memory"); __builtin_amdgcn_s_barrier(); asm volatile("" ::: "memory");
}
__device__ __forceinline__ int opaque_s(int x) { asm volatile("" : "+s"(x)); return x; }
template <class T> __device__ __forceinline__ T* opaque_p(T* p) { asm volatile("" : "+s"(p)); return p; }
__device__ __forceinline__ int opaque_tid(int wv) { unsigned z = 0u; asm volatile("" : "+s"(z)); int t = opaque_s(wv) * 64 + (int)__builtin_amdgcn_mbcnt_hi(~0u, __builtin_amdgcn_mbcnt_lo(~0u, z)); asm volatile("" : "+v"(t)); return t; }

namespace pg8 {
constexpr int BM = 256, BK = 64, HALF = 128, HTB = HALF * BK * 2, STAGE_BYTES = 8 * HTB, NXCD = 8, WGM = 8;
__host__ __device__ __forceinline__ int lds_byte(int r, int c) { const int st = (r >> 4) * 2 + (c >> 5), rr = r & 15, cc = c & 31, ob = rr * 64 + cc * 2; return st * 1024 + (ob ^ (((ob >> 9) & 1) << 5)); }
__host__ __device__ __forceinline__ void stage_rc(int b, int& R, int& C) { const int st = b / 1024, sb = b % 1024, swz = sb ^ (((sb >> 9) & 1) << 5); R = (st >> 1) * 16 + swz / 64; C = (st & 1) * 32 + (swz % 64) / 2; }
__host__ __device__ __forceinline__ int perm32(int rho) { const int n = rho >> 4, i = rho & 15; return 8 * (i >> 2) + 4 * n + (i & 3); }

struct Unit { int pm, pn, kc; };
struct Gemm { const bf16_t* A; const bf16_t* Bt; int lda, ldb, K, nM, nN, ablk; };

struct StaticOrder {
    int nM, nN, nwg, G, c;
    __device__ void init(int nM_, int nN_, int G_, int c_) { nM = nM_; nN = nN_; nwg = nM * nN; G = G_; c = c_; }
    static constexpr bool SPLIT = false;
    __device__ bool next(int i, Unit& u) const {
        const long L = (long)i * G + c; if (L >= nwg) return false;
        u.kc = -1;
        int wgid = (int)L; { const int q = nwg / NXCD, r = nwg % NXCD, xcd = wgid % NXCD, off = wgid / NXCD; wgid = (xcd < r ? xcd * (q + 1) : r * (q + 1) + (xcd - r) * q) + off; }
        const int nig = WGM * nN, gid = wgid / nig, fm = gid * WGM, gsz = (nM - fm) < WGM ? (nM - fm) : WGM;
        u.pm = fm + ((wgid % nig) % gsz); u.pn = (wgid % nig) / gsz; return true;
    }
};

struct DownOrder {
    int G, c;
    static constexpr bool SPLIT = true;
    __device__ void init(int G_, int c_) { G = G_; c = c_; }
    __device__ bool next(int i, Unit& u) const {
        const int L = i * G + c; if (L >= 256 + 96) return false;
        const bool full = L < 256; const int r = L >> 3, idx = L - 256, tile = idx / 6;
        const int pm = full ? (L & 7) * 8 + (r & 7) : 64 + (tile >> 2), pn = full ? (r >> 3) : (tile & 3), kc = full ? -1 : idx - tile * 6;
        u.pm = pm; u.pn = pn; u.kc = kc;
        return true;
    }
};

template <class Epi, class Sched>
__device__ __forceinline__ void gemm_phase(LAS unsigned char* lds, const Gemm g, const Sched& S, const Epi& E, int wv) {
    const int tid = opaque_tid(wv), wid = __builtin_amdgcn_readfirstlane(tid >> 6), lane = tid & 63, wr = wid >> 2, wc = wid & 3, fr = lane & 15, fq = lane >> 4;
    const int K = opaque_s(g.K), nt = K / BK;
    unsigned voffA[2], voffB[2];
#pragma unroll
    for (int i = 0; i < 2; ++i) { int R, C; stage_rc(tid * 16 + i * 8192, R, C); const int Rb = (R & ~31) + perm32(R & 31);
        voffA[i] = (unsigned)(R * g.lda + C) * 2u; voffB[i] = (unsigned)(Rb * g.ldb + C) * 2u; }
    const size_t kstep = (size_t)(BK * 2);
    const size_t hstepA = (size_t)HALF * g.lda * 2, hstepB = (size_t)HALF * g.ldb * 2;
    const unsigned ldsw = (unsigned)wid * 1024u;
    const int aoff = lds_byte(wr * 64 + fr, fq * 8), boff = lds_byte(wc * 32 + fr, fq * 8);
#define PG8_SA(b, h) (((b) * 2 + (h)) * HTB)
#define PG8_SB(b, h) ((4 + (b) * 2 + (h)) * HTB)
#define PG8_STAGE(bufoff, gbase, voff) do { _Pragma("unroll") for (int _i = 0; _i < 2; ++_i) \
        __builtin_amdgcn_global_load_lds((const unsigned*)((const char*)(gbase) + (voff)[_i]), (LAS unsigned*)(lds + (bufoff) + ldsw + _i * 8192), 16, 0, 0); } while (0)
#define PG8_LDA(dst, b, h) do { _Pragma("unroll") for (int m = 0; m < 4; ++m) _Pragma("unroll") for (int k = 0; k < 2; ++k) dst[m][k] = *(const LAS bf16x8*)(lds + PG8_SA(b, h) + aoff + m * 2048 + k * 1024); } while (0)
#define PG8_LDB(dst, b, h) do { _Pragma("unroll") for (int n = 0; n < 2; ++n) _Pragma("unroll") for (int k = 0; k < 2; ++k) dst[n][k] = *(const LAS bf16x8*)(lds + PG8_SB(b, h) + boff + n * 2048 + k * 1024); } while (0)
#define PG8_MMA(ai, bj, At, Bt) do { __builtin_amdgcn_s_setprio(1); _Pragma("unroll") for (int m = 0; m < 4; ++m) _Pragma("unroll") for (int n = 0; n < 2; ++n) _Pragma("unroll") for (int k = 0; k < 2; ++k) \
        acc[ai][bj][m][n] = __builtin_amdgcn_mfma_f32_16x16x32_bf16(Bt[n][k], At[m][k], acc[ai][bj][m][n], 0, 0, 0); __builtin_amdgcn_s_setprio(0); } while (0)
#define PG8_WAIT_V(n) asm volatile("s_waitcnt vmcnt(" #n ")" ::: "memory")
#define PG8_WAIT_L(n) asm volatile("s_waitcnt lgkmcnt(" #n ")" ::: "memory")
#define PG8_BAR __builtin_amdgcn_s_barrier()
#define PG8_SCHED __builtin_amdgcn_sched_barrier(0)
#define PG8_KOFF(u) ((Sched::SPLIT && (u).kc > 0) ? (size_t)(u).kc * 1024 : (size_t)0)
#define PG8_ABASE(u) ((const char*)g.A + (size_t)(u).pm * 2 * hstepA + (g.ablk ? (size_t)((u).pn >> 1) * 512 : 0) + PG8_KOFF(u))
#define PG8_BBASE(u) ((const char*)g.Bt + (size_t)(u).pn * 2 * hstepB + PG8_KOFF(u))
#define PG8_NT(u) ((Sched::SPLIT && (u).kc >= 0) ? ((u).kc < 5 ? 8 : 4) : nt)
    Unit cur, nxt; int ui = 0;
    if (!S.next(0, cur)) return;
    f32x4 acc[2][2][4][2];
#pragma unroll
    for (int a = 0; a < 2; ++a)
#pragma unroll
        for (int b = 0; b < 2; ++b)
#pragma unroll
            for (int m = 0; m < 4; ++m)
#pragma unroll
                for (int n = 0; n < 2; ++n) acc[a][b][m][n] = (f32x4){0.f, 0.f, 0.f, 0.f};
    bf16x8 At[4][2], B0[2][2], B1[2][2];
    f32x4 pf[4] = {{0.f, 0.f, 0.f, 0.f}, {0.f, 0.f, 0.f, 0.f}, {0.f, 0.f, 0.f, 0.f}, {0.f, 0.f, 0.f, 0.f}};
    const char* cA = PG8_ABASE(cur); const char* cB = PG8_BBASE(cur);
    PG8_STAGE(PG8_SB(0, 0), cB, voffB); PG8_STAGE(PG8_SB(0, 1), cB + hstepB, voffB); PG8_STAGE(PG8_SA(0, 0), cA, voffA); PG8_STAGE(PG8_SA(0, 1), cA + hstepA, voffA);
    if (wr == 1) PG8_BAR;
    PG8_WAIT_V(2); PG8_BAR;
    PG8_STAGE(PG8_SB(1, 0), cB + kstep, voffB); PG8_STAGE(PG8_SA(1, 0), cA + kstep, voffA); PG8_STAGE(PG8_SB(1, 1), cB + hstepB + kstep, voffB);
    PG8_WAIT_V(6); PG8_BAR;
    for (;;) {
        const bool has_next = S.next(ui + 1, nxt);
        const char* nA = has_next ? PG8_ABASE(nxt) : cA; const char* nB = has_next ? PG8_BBASE(nxt) : cB;
        const int ntu = PG8_NT(cur);
#pragma unroll 1
        for (int t = 0; t < ntu; t += 2) {
            const bool last = (t == ntu - 2);
            if (last) E.prefetch(pf, cur, tid);
            const char* a1 = cA + (size_t)(t + 1) * kstep;
            const char* a2 = last ? nA : cA + (size_t)(t + 2) * kstep; const char* b2 = last ? nB : cB + (size_t)(t + 2) * kstep;
            const char* a3 = a2 + kstep; const char* b3 = b2 + kstep;
            PG8_LDB(B0, 0, 0); PG8_LDB(B1, 0, 1); PG8_SCHED; PG8_LDA(At, 0, 0); PG8_STAGE(PG8_SA(1, 1), a1 + hstepA, voffA);
            PG8_WAIT_V(8); PG8_WAIT_L(0); PG8_BAR; PG8_MMA(0, 0, At, B0); PG8_MMA(0, 1, At, B1); PG8_BAR; PG8_SCHED;
            PG8_LDA(At, 0, 1); PG8_STAGE(PG8_SB(0, 0), b2, voffB); PG8_STAGE(PG8_SB(0, 1), b2 + hstepB, voffB); PG8_STAGE(PG8_SA(0, 0), a2, voffA);
            PG8_WAIT_V(8); PG8_WAIT_L(0); PG8_BAR; PG8_MMA(1, 0, At, B0); PG8_MMA(1, 1, At, B1); PG8_BAR; PG8_SCHED;
            PG8_LDB(B0, 1, 0); PG8_LDB(B1, 1, 1); PG8_SCHED; PG8_LDA(At, 1, 0); PG8_STAGE(PG8_SA(0, 1), a2 + hstepA, voffA);
            PG8_WAIT_V(8); PG8_WAIT_L(0); PG8_BAR; PG8_MMA(0, 0, At, B0); PG8_MMA(0, 1, At, B1); PG8_BAR; PG8_SCHED;
            PG8_LDA(At, 1, 1); PG8_STAGE(PG8_SB(1, 0), b3, voffB); PG8_STAGE(PG8_SB(1, 1), b3 + hstepB, voffB); PG8_STAGE(PG8_SA(1, 0), a3, voffA);
            PG8_WAIT_V(8); PG8_WAIT_L(0); PG8_BAR; PG8_MMA(1, 0, At, B0); PG8_MMA(1, 1, At, B1); PG8_BAR; PG8_SCHED;
        }
        if (wr == 0) PG8_BAR;
        E(acc, cur, wr, wc, fr, fq, pf);
        if (!has_next) break;
#pragma unroll
        for (int a = 0; a < 2; ++a)
#pragma unroll
            for (int b = 0; b < 2; ++b)
#pragma unroll
                for (int m = 0; m < 4; ++m)
#pragma unroll
                    for (int n = 0; n < 2; ++n) acc[a][b][m][n] = (f32x4){0.f, 0.f, 0.f, 0.f};
        cur = nxt; cA = nA; cB = nB; ++ui;
        if (wr == 1) PG8_BAR;
    }
    PG8_WAIT_V(0);
    PG8_BAR;
#undef PG8_SA
#undef PG8_SB
#undef PG8_STAGE
#undef PG8_LDA
#undef PG8_LDB
#undef PG8_MMA
#undef PG8_WAIT_V
#undef PG8_WAIT_L
#undef PG8_BAR
#undef PG8_SCHED
#undef PG8_ABASE
#undef PG8_BBASE
#undef PG8_KOFF
#undef PG8_NT
}
}
using pg8::Unit; using pg8::HALF;

struct EpiSwiGLU {
    bf16_t* ACT; const float* ss; LAS float* rsl;
    __device__ __forceinline__ void prefetch(f32x4 (&pf)[4], const Unit& u, int tid) const { rstd_prefetch(pf, ss, u.pm, tid); }
    __device__ __forceinline__ void operator()(const f32x4 (&acc)[2][2][4][2], const Unit& u, int wr, int wc, int fr, int fq, const f32x4 (&pf)[4]) const {
        const int row0 = u.pm * 256 + wr * 64 + fr, col0 = u.pn * 128 + wc * 32 + 8 * fq;
        unit_rstd(pf, rsl, (wr * 4 + wc) * 64 + fq * 16 + fr);
        float rsv[2][4];
#pragma unroll
        for (int ai = 0; ai < 2; ++ai)
#pragma unroll
            for (int m = 0; m < 4; ++m) rsv[ai][m] = rsl[ai * HALF + wr * 64 + m * 16 + fr];
#pragma unroll
        for (int ai = 0; ai < 2; ++ai)
#pragma unroll
            for (int m = 0; m < 4; ++m) {
                const int row = row0 + ai * HALF + m * 16; const float rs = rsv[ai][m];
                float h[8];
#pragma unroll
                for (int n = 0; n < 2; ++n)
#pragma unroll
                    for (int j = 0; j < 4; ++j) h[n * 4 + j] = silu_(acc[ai][0][m][n][j] * rs) * (acc[ai][1][m][n][j] * rs);
                u32x4 w; w.x = cvt_pk_bf16(h[0], h[1]); w.y = cvt_pk_bf16(h[2], h[3]); w.z = cvt_pk_bf16(h[4], h[5]); w.w = cvt_pk_bf16(h[6], h[7]);
                st16_wt(ACT + (size_t)row * DFF + col0, w);
            }
    }
};
struct EpiResid {
    float* X; bf16_t* XB; float* ssn; float scale; float* PART;
    __device__ __forceinline__ void prefetch(f32x4 (&)[4], const Unit&, int) const {}
    __device__ __forceinline__ void operator()(const f32x4 (&acc)[2][2][4][2], const Unit& u, int wr, int wc, int fr, int fq, const f32x4 (&pf)[4]) const {
        const int row0 = u.pm * 256 + wr * 64 + fr, col0 = u.pn * 256 + wc * 32 + 8 * fq;
        if (u.kc >= 0) {
#pragma unroll
            for (int ai = 0; ai < 2; ++ai)
#pragma unroll
                for (int m = 0; m < 4; ++m) {
                    const int row = row0 + ai * HALF + m * 16 - MP;
#pragma unroll
                    for (int bj = 0; bj < 2; ++bj) { float* pp = PART + ((size_t)u.kc * MS + row) * D + col0 + bj * HALF; *(GAS f32x4*)pp = acc[ai][bj][m][0]; *(GAS f32x4*)(pp + 4) = acc[ai][bj][m][1]; }
                }
            return;
        }
        u32x4 oldx[2][4][2];
#pragma unroll
        for (int ai = 0; ai < 2; ++ai)
#pragma unroll
            for (int m = 0; m < 4; ++m)
#pragma unroll
                for (int bj = 0; bj < 2; ++bj) oldx[ai][m][bj] = *(const GAS u32x4*)(XB + (size_t)(row0 + ai * HALF + m * 16) * D + col0 + bj * HALF);
#pragma unroll
        for (int ai = 0; ai < 2; ++ai)
#pragma unroll
            for (int m = 0; m < 4; ++m) {
                const int row = row0 + ai * HALF + m * 16; float s = 0.f;
#pragma unroll
                for (int bj = 0; bj < 2; ++bj) {
                    bf16_t* xp = XB + (size_t)row * D + col0 + bj * HALF;
                    const u32x4 o = oldx[ai][m][bj];
                    f32x4 a = (f32x4){bf_lo(o.x), bf_hi(o.x), bf_lo(o.y), bf_hi(o.y)}, b = (f32x4){bf_lo(o.z), bf_hi(o.z), bf_lo(o.w), bf_hi(o.w)};
                    a = a + acc[ai][bj][m][0] * scale; b = b + acc[ai][bj][m][1] * scale;
                    u32x4 w; w.x = cvt_pk_bf16(a.x, a.y); w.y = cvt_pk_bf16(a.z, a.w); w.z = cvt_pk_bf16(b.x, b.y); w.w = cvt_pk_bf16(b.z, b.w);
                    st16_wt(xp, w);
                    a = (f32x4){bf_lo(w.x), bf_hi(w.x), bf_lo(w.y), bf_hi(w.y)}; b = (f32x4){bf_lo(w.z), bf_hi(w.z), bf_lo(w.w), bf_hi(w.w)};
                    s += (a.x * a.x + a.y * a.y) + (a.z * a.z + a.w * a.w) + (b.x * b.x + b.y * b.y) + (b.z * b.z + b.w * b.w);
                }
                s += __shfl_xor(s, 16); s += __shfl_xor(s, 32);
                if (fq == 0) *(GAS float*)(ssn + (size_t)row * 16 + u.pn * 4 + wc) = s;
            }
    }
};
struct EpiRgIn {
    bf16_t* GG; bf16_t* XR; const float* ss; LAS float* rsl;
    __device__ __forceinline__ void prefetch(f32x4 (&pf)[4], const Unit& u, int tid) const { rstd_prefetch(pf, ss, u.pm, tid); }
    __device__ __forceinline__ void operator()(const f32x4 (&acc)[2][2][4][2], const Unit& u, int wr, int wc, int fr, int fq, const f32x4 (&pf)[4]) const {
        const int row0 = u.pm * 256 + wr * 64 + fr, col0 = (u.pn & 3) * 256 + wc * 32 + 8 * fq;
        const bool is_gate = u.pn < 4;
        unit_rstd(pf, rsl, (wr * 4 + wc) * 64 + fq * 16 + fr);
#pragma unroll
        for (int ai = 0; ai < 2; ++ai)
#pragma unroll
            for (int m = 0; m < 4; ++m) {
                const int row = row0 + ai * HALF + m * 16; const float rs = rsl[ai * HALF + wr * 64 + m * 16 + fr];
#pragma unroll
                for (int bj = 0; bj < 2; ++bj) {
                    const f32x4 a = acc[ai][bj][m][0] * rs, b = acc[ai][bj][m][1] * rs;
                    const size_t off = (size_t)row * D + col0 + bj * HALF;
                    if (is_gate) {
                        u32x4 w; w.x = cvt_pk_bf16(gelu_tanh_(a.x), gelu_tanh_(a.y)); w.y = cvt_pk_bf16(gelu_tanh_(a.z), gelu_tanh_(a.w));
                        w.z = cvt_pk_bf16(gelu_tanh_(b.x), gelu_tanh_(b.y)); w.w = cvt_pk_bf16(gelu_tanh_(b.z), gelu_tanh_(b.w));
                        *(GAS u32x4*)(GG + off) = w;
                    } else { u32x4 w; w.x = cvt_pk_bf16(a.x, a.y); w.y = cvt_pk_bf16(a.z, a.w); w.z = cvt_pk_bf16(b.x, b.y); w.w = cvt_pk_bf16(b.z, b.w); *(GAS u32x4*)(XR + off) = w; }
                }
            }
    }
};
struct EpiGates {
    unsigned char* MIXp; const float* tab;
    __device__ __forceinline__ void prefetch(f32x4 (&)[4], const Unit&, int) const {}
    __device__ __forceinline__ void operator()(const f32x4 (&acc)[2][2][4][2], const Unit& u, int wr, int wc, int fr, int fq, const f32x4 (&pf)[4]) const {
        const int row0 = u.pm * 256 + wr * 64 + fr, ch0 = (u.pn >> 1) * 256 + (u.pn & 1) * 128 + wc * 32 + 8 * fq;
        u32x4 xcw[2][4]; f32x4 ba[2], bx[2], sp[2];
#pragma unroll
        for (int ai = 0; ai < 2; ++ai)
#pragma unroll
            for (int m = 0; m < 4; ++m) xcw[ai][m] = *(const GAS u32x4*)((const bf16_t*)(MIXp + MIX_XC) + (size_t)(row0 + ai * HALF + m * 16) * D + ch0);
#pragma unroll
        for (int n = 0; n < 2; ++n) { ba[n] = *(const GAS f32x4*)(tab + ch0 + 4 * n); bx[n] = *(const GAS f32x4*)(tab + D + ch0 + 4 * n); sp[n] = *(const GAS f32x4*)(tab + 2 * D + ch0 + 4 * n); }
#pragma unroll
        for (int ai = 0; ai < 2; ++ai)
#pragma unroll
            for (int m = 0; m < 4; ++m) {
                const int row = row0 + ai * HALF + m * 16; const size_t off = (size_t)row * D + ch0;
                const u32x4 xw = xcw[ai][m];
                const float xc[8] = {bf_lo(xw.x), bf_hi(xw.x), bf_lo(xw.y), bf_hi(xw.y), bf_lo(xw.z), bf_hi(xw.z), bf_lo(xw.w), bf_hi(xw.w)};
                h16x8 la8, u8;
#pragma unroll
                for (int n = 0; n < 2; ++n) {
#pragma unroll
                    for (int jx = 0; jx < 4; ++jx) {
                        const float r = sigmoidf_(acc[ai][0][m][n][jx] + ba[n][jx]), ig = sigmoidf_(acc[ai][1][m][n][jx] + bx[n][jx]);
                        const float la = r * sp[n][jx], x2 = 2.f * la;
                        const float om = (x2 > -0.03f) ? -x2 * (1.f + x2 * (0.5f + x2 * (0.16666667f + x2 * 0.041666668f))) : 1.f - __expf(x2);
                        const float uu = sqrtf(fmaxf(om, 0.f)) * (ig * xc[n * 4 + jx]);
                        la8[n * 4 + jx] = (_Float16)la; u8[n * 4 + jx] = (_Float16)uu;
                    }
                }
                { union { h16x8 h; u32x4 u; } c0, c1; c0.h = la8; c1.h = u8; st16_wt((_Float16*)(MIXp + MIX_XR) + off, c0.u); st16_wt((_Float16*)(MIXp + MIX_U) + off, c1.u); }
            }
    }
};
struct EpiQ {
    bf16_t* Q; const float* ss; LAS float* rsl;
    __device__ __forceinline__ void prefetch(f32x4 (&pf)[4], const Unit& u, int tid) const { rstd_prefetch(pf, ss, u.pm, tid); }
    __device__ __forceinline__ void operator()(const f32x4 (&acc)[2][2][4][2], const Unit& u, int wr, int wc, int fr, int fq, const f32x4 (&pf)[4]) const {
        const int row0 = u.pm * 256 + wr * 64 + fr, col0 = u.pn * 256 + wc * 32 + 8 * fq;
        unit_rstd(pf, rsl, (wr * 4 + wc) * 64 + fq * 16 + fr);
        float rsv[2][4];
#pragma unroll
        for (int ai = 0; ai < 2; ++ai)
#pragma unroll
            for (int m = 0; m < 4; ++m) rsv[ai][m] = rsl[ai * HALF + wr * 64 + m * 16 + fr];
#pragma unroll
        for (int ai = 0; ai < 2; ++ai)
#pragma unroll
            for (int m = 0; m < 4; ++m) {
                const int row = row0 + ai * HALF + m * 16; const float rs = rsv[ai][m];
#pragma unroll
                for (int bj = 0; bj < 2; ++bj) {
                    const f32x4 a = acc[ai][bj][m][0] * rs, b = acc[ai][bj][m][1] * rs;
                    u32x4 w; w.x = cvt_pk_bf16(a.x, a.y); w.y = cvt_pk_bf16(a.z, a.w); w.z = cvt_pk_bf16(b.x, b.y); w.w = cvt_pk_bf16(b.z, b.w);
                    st16_wt(Q + (size_t)row * D + col0 + bj * HALF, w);
                }
            }
    }
};
struct EpiKV {
    bf16_t* KVB; float* out; const float* ss; LAS float* rsl;
    __device__ __forceinline__ void prefetch(f32x4 (&pf)[4], const Unit& u, int tid) const { rstd_prefetch(pf, ss, u.pm, tid); }
    __device__ __forceinline__ void operator()(const f32x4 (&acc)[2][2][4][2], const Unit& u, int wr, int wc, int fr, int fq, const f32x4 (&pf)[4]) const {
        const int row0 = u.pm * 256 + wr * 64 + fr, col0 = wc * 32 + 8 * fq;
        unit_rstd(pf, rsl, (wr * 4 + wc) * 64 + fq * 16 + fr);
#pragma unroll
        for (int ai = 0; ai < 2; ++ai)
#pragma unroll
            for (int m = 0; m < 4; ++m) {
                const int row = row0 + ai * HALF + m * 16; const float rs = rsl[ai * HALF + wr * 64 + m * 16 + fr];
                long obase = -1;
                size_t okoff = O_PK, ovoff = O_PV;
                if (row < MP) { const int b = row >> 12, t = row & 4095; if (t >= SEQ - 128) obase = ((long)b * 128 + (t - (SEQ - 128))) * 128; }
                else { const int s = (row - MP) >> 3, i = (row - MP) & 7; obase = ((long)s * 128 + 120 + i) * 128; okoff = O_SK; ovoff = O_SV; }
#pragma unroll
                for (int bj = 0; bj < 2; ++bj) {
                    const f32x4 a = acc[ai][bj][m][0] * rs, b = acc[ai][bj][m][1] * rs;
                    u32x4 w; w.x = cvt_pk_bf16(a.x, a.y); w.y = cvt_pk_bf16(a.z, a.w); w.z = cvt_pk_bf16(b.x, b.y); w.w = cvt_pk_bf16(b.z, b.w);
                    *(GAS u32x4*)(KVB + (size_t)row * 256 + bj * HALF + col0) = w;
                    if (obase >= 0) { float* o = out + (bj ? ovoff : okoff) + obase + col0; *(GAS f32x4*)o = a; *(GAS f32x4*)(o + 4) = b; }
                }
            }
    }
};

__device__ __forceinline__ void prep_macro(const float* s0, const float* s1, const float* s2, const float* s3, int ldsrc, int k0, const float* gain, float cs, bf16_t* dst, int ldd, int n0, LAS float* scr, int tid) {
    const float* srcq[4] = {s0, s1, s2, s3};
    f32x4 v[4][2];
#pragma unroll
    for (int q = 0; q < 4; ++q)
#pragma unroll
        for (int i = 0; i < 2; ++i) { const int kk = (tid >> 4) + 32 * i, cc = (tid & 15) * 4; v[q][i] = *(const f32x4*)(srcq[q] + (size_t)(k0 + kk) * ldsrc + cc); }
    float g[2];
#pragma unroll
    for (int i = 0; i < 2; ++i) g[i] = gain ? cs * gain[k0 + (tid >> 4) + 32 * i] : cs;
#pragma unroll
    for (int q = 0; q < 4; ++q)
#pragma unroll
        for (int i = 0; i < 2; ++i) { const int kk = (tid >> 4) + 32 * i, cc = (tid & 15) * 4; LAS float* s = scr + q * 4160 + kk * 65 + cc;
            s[0] = v[q][i].x * g[i]; s[1] = v[q][i].y * g[i]; s[2] = v[q][i].z * g[i]; s[3] = v[q][i].w * g[i]; }
    __syncthreads();
    const int n = tid >> 3, c = tid & 7;
#pragma unroll
    for (int q = 0; q < 4; ++q) { const LAS float* s = scr + q * 4160 + (8 * c) * 65 + n;
        u32x4 o; o.x = cvt_pk_bf16(s[0], s[65]); o.y = cvt_pk_bf16(s[130], s[195]); o.z = cvt_pk_bf16(s[260], s[325]); o.w = cvt_pk_bf16(s[390], s[455]);
        *(u32x4*)(dst + (size_t)(n0 + 64 * q + n) * ldd + k0 + 8 * c) = o; }
    __syncthreads();
}
__device__ __forceinline__ void prep_plain(const float* src, int ldsrc, int kt, int nt4, const float* gain, float cs, bf16_t* dst, int ldd, LAS float* scr, int tid) {
    const float* b = src + 256 * nt4; prep_macro(b, b + 64, b + 128, b + 192, ldsrc, kt * 64, gain, cs, dst, ldd, 256 * nt4, scr, tid);
}

__device__ __forceinline__ void phase_prep(const Params& P, LAS unsigned char* lds, int wv) {
    const int tid = opaque_tid(wv), lane = tid & 63, wave = tid >> 6, G = opaque_s((int)gridDim.x), bid = opaque_s((int)blockIdx.x);
    LAS float* scr = (LAS float*)lds;
    bf16_t* W = (bf16_t*)(P.ws + WS_W);
    constexpr int I_GU = 8 * 352, I_D = I_GU + 8 * 176, I_IN = I_D + 2 * 128, I_OUT = I_IN + 2 * 64, I_KV = I_OUT + 16, I_Q = I_KV + 2 * 64, I_O = I_Q + 2 * 64, I_G = I_O + 2 * 32;
    for (int it = bid; it < I_G; it += G) {
        if (it < I_GU) { const int j = it / 352, r = it % 352, l = j >> 1, f = j & 1, kt = r & 15, pn = r >> 4;
            const float* b = P.in[f ? 11 : 7] + (size_t)l * D * NGU + 128 * pn;
            prep_macro(b, b + 64, b + DFF, b + DFF + 64, NGU, kt * 64, P.in[f ? 10 : 6] + l * D, 1.f, W + W_GU + (size_t)j * NGU * D, D, 256 * pn, scr, tid);
        } else if (it < I_D) { const int q = it - I_GU, j = q / 176, r = q % 176, l = j >> 1, f = j & 1, kt = r % 44, nt4 = r / 44;
            prep_plain(P.in[f ? 12 : 8] + (size_t)l * DFF * D, D, kt, nt4, nullptr, 1.f, W + W_D + (size_t)j * D * DFF, DFF, scr, tid);
        } else if (it < I_IN) { const int q = it - I_D, l = q / 128, r = q % 128, kt = r & 15, nt4 = r >> 4;
            prep_plain(P.in[13] + (size_t)l * D * 2048, 2048, kt, nt4, P.in[9] + l * D, 1.f, W + W_IN + (size_t)l * 2048 * D, D, scr, tid);
        } else if (it < I_OUT) { const int q = it - I_IN, l = q / 64, r = q % 64, kt = r & 15, nt4 = r >> 4;
            prep_plain(P.in[21] + (size_t)l * D * D, D, kt, nt4, nullptr, 1.f, W + W_OUT + (size_t)l * D * D, D, scr, tid);
        } else if (it < I_KV) { const int r = it - I_OUT, kt = r & 15;
            prep_plain(P.in[23], 256, kt, 0, P.in[22], 1.f, W + W_KV, D, scr, tid);
        } else if (it < I_Q) { const int q = it - I_KV, l = q / 64, r = q % 64, kt = r & 15, nt4 = r >> 4;
            prep_plain(P.in[24] + (size_t)l * D * D, D, kt, nt4, P.in[9] + (2 + l) * D, 0.125f, W + W_Q + (size_t)l * D * D, D, scr, tid);
        } else if (it < I_O) { const int q = it - I_Q, l = q / 64, r = q % 64, kt = r & 15, nt4 = r >> 4;
            prep_plain(P.in[26] + (size_t)l * D * D, D, kt, nt4, nullptr, 1.f, W + W_O + (size_t)l * D * D, D, scr, tid);
        } else { const int q = it - I_O, l = q / 32, r = q % 32, kt = r & 3, pn = r >> 2, nb = pn >> 1, hh = pn & 1;
            const float* a = P.in[16] + (size_t)l * 4 * 65536 + (size_t)nb * 65536 + hh * 128; const float* x = P.in[18] + (size_t)l * 4 * 65536 + (size_t)nb * 65536 + hh * 128;
            prep_macro(a, a + 64, x, x + 64, 256, kt * 64, nullptr, 1.f, W + W_G + (size_t)l * 2048 * 256, 256, 256 * pn, scr, tid);
        }
    }
    float* X = P.out + O_X; bf16_t* XB = (bf16_t*)(P.ws + WS_XB); float* SS = (float*)(P.ws + WS_SSP);
    const int gw = bid * 8 + wave, NGW = G * 8;
    for (int row = gw; row < M; row += 2 * NGW) {
        const int row2 = row + NGW; const bool has2 = row2 < M; const int r2 = has2 ? row2 : row;
        const float* src = row < MP ? P.in[0] + (size_t)row * D : P.in[1] + (size_t)(row - MP) * D;
        const float* src2 = r2 < MP ? P.in[0] + (size_t)r2 * D : P.in[1] + (size_t)(r2 - MP) * D;
        f32x4 v[4], v2[4];
#pragma unroll
        for (int j = 0; j < 4; ++j) { v[j] = *(const f32x4*)(src + j * 256 + lane * 4); v2[j] = *(const f32x4*)(src2 + j * 256 + lane * 4); }
        float s = 0.f, s2 = 0.f;
#pragma unroll
        for (int j = 0; j < 4; ++j) {
            u32x2 w; w.x = cvt_pk_bf16(v[j].x, v[j].y); w.y = cvt_pk_bf16(v[j].z, v[j].w);
            *(u32x2*)(XB + (size_t)row * D + j * 256 + lane * 4) = w;
            const f32x4 q = (f32x4){bf_lo(w.x), bf_hi(w.x), bf_lo(w.y), bf_hi(w.y)};
            s += (q.x * q.x + q.y * q.y) + (q.z * q.z + q.w * q.w);
            u32x2 w2; w2.x = cvt_pk_bf16(v2[j].x, v2[j].y); w2.y = cvt_pk_bf16(v2[j].z, v2[j].w);
            if (has2) *(u32x2*)(XB + (size_t)row2 * D + j * 256 + lane * 4) = w2;
            const f32x4 q2 = (f32x4){bf_lo(w2.x), bf_hi(w2.x), bf_lo(w2.y), bf_hi(w2.y)};
            s2 += (q2.x * q2.x + q2.y * q2.y) + (q2.z * q2.z + q2.w * q2.w);
        }
#pragma unroll
        for (int o = 1; o < 64; o <<= 1) { s += __shfl_xor(s, o); s2 += __shfl_xor(s2, o); }
        if (lane < 16) { SS[(size_t)row * 16 + lane] = lane == 0 ? s : 0.f; if (has2) SS[(size_t)row2 * 16 + lane] = lane == 0 ? s2 : 0.f; }
    }
    const int gt = bid * NTHR + tid, NGT = G * NTHR;
    if (gt < 2 * D) { const int l = gt >> 10, c = gt & 1023; const float z = -P.in[20][gt]; float* tab = (float*)(P.ws + WS_SPT) + l * 3 * D;
        tab[c] = P.in[17][gt]; tab[D + c] = P.in[19][gt]; tab[2 * D + c] = -8.0f * (fmaxf(z, 0.f) + log1pf(expf(-fabsf(z)))); }
    bf16_t* CKB = (bf16_t*)(P.ws + WS_CKB);
    for (int i = gt; i < 2 * DB * 4096; i += NGT) {
        const int which = i / (DB * 4096), r = i % (DB * 4096), s = r / 4096, q = r % 4096;
        const f32x4 v = *(const f32x4*)(P.in[4 + which] + (size_t)s * 16384 + q * 4);
        if (q >= 256) *(f32x4*)(P.out + (which ? O_SV : O_SK) + (size_t)s * 16384 + (q - 256) * 4) = v;
        u32x2 w; w.x = cvt_pk_bf16(v.x, v.y); w.y = cvt_pk_bf16(v.z, v.w);
        *(u32x2*)(CKB + (size_t)which * DB * 16384 + (size_t)s * 16384 + q * 4) = w;
    }
}

__device__ __forceinline__ void phase_conv(const Params& P, int l, int wv) {
    const int tid = opaque_tid(wv), rc = tid >> 7, c8 = (tid & 127) * 8;
    const bf16_t* XR = (const bf16_t*)(P.ws + WS_MIX + MIX_XR); bf16_t* XC = (bf16_t*)(P.ws + WS_MIX + MIX_XC);
    const float* cw = P.in[14] + (size_t)l * 4 * D; const float* cb = P.in[15] + (size_t)l * D;
    float w[4][8], bb[8];
#pragma unroll
    for (int k = 0; k < 4; ++k) { const f32x4 a = *(const f32x4*)(cw + k * D + c8), b = *(const f32x4*)(cw + k * D + c8 + 4);
        w[k][0] = a.x; w[k][1] = a.y; w[k][2] = a.z; w[k][3] = a.w; w[k][4] = b.x; w[k][5] = b.y; w[k][6] = b.z; w[k][7] = b.w; }
    { const f32x4 a = *(const f32x4*)(cb + c8), b = *(const f32x4*)(cb + c8 + 4); bb[0] = a.x; bb[1] = a.y; bb[2] = a.z; bb[3] = a.w; bb[4] = b.x; bb[5] = b.y; bb[6] = b.z; bb[7] = b.w; }
    for (int u = opaque_s((int)blockIdx.x); u < M / 32; u += opaque_s((int)gridDim.x)) {
        const int r0 = u * 32 + rc * 8;
        const bool samp = r0 >= MP; const int t0 = samp ? 0 : (r0 & 4095); const int sq = samp ? (r0 - MP) >> 3 : (r0 >> 12);
        float h[3][8];
#pragma unroll
        for (int k = 0; k < 3; ++k) {
            if (t0 > 0) { const u32x4 w = *(const u32x4*)(XR + (size_t)(r0 - 3 + k) * D + c8);
                h[k][0] = bf_lo(w.x); h[k][1] = bf_hi(w.x); h[k][2] = bf_lo(w.y); h[k][3] = bf_hi(w.y); h[k][4] = bf_lo(w.z); h[k][5] = bf_hi(w.z); h[k][6] = bf_lo(w.w); h[k][7] = bf_hi(w.w); }
            else if (samp) { const float* src = P.in[3] + (((size_t)l * DB + sq) * 3 + k) * D + c8;
                const f32x4 a = *(const f32x4*)src, b = *(const f32x4*)(src + 4); h[k][0] = a.x; h[k][1] = a.y; h[k][2] = a.z; h[k][3] = a.w; h[k][4] = b.x; h[k][5] = b.y; h[k][6] = b.z; h[k][7] = b.w; }
            else {
#pragma unroll
                for (int e = 0; e < 8; ++e) h[k][e] = 0.f; }
        }
        const bool tail = samp || (t0 == SEQ - 8);
        float* so = P.out + (samp ? O_SC + (((size_t)l * DB + sq) * 3) * D : O_PC + (((size_t)l * NSEQ + sq) * 3) * D) + c8;
        u32x4 xrow[8];
#pragma unroll
        for (int i = 0; i < 8; ++i) xrow[i] = *(const u32x4*)(XR + (size_t)(r0 + i) * D + c8);
#pragma unroll
        for (int i = 0; i < 8; ++i) {
            const u32x4 xw = xrow[i];
            const float cur[8] = {bf_lo(xw.x), bf_hi(xw.x), bf_lo(xw.y), bf_hi(xw.y), bf_lo(xw.z), bf_hi(xw.z), bf_lo(xw.w), bf_hi(xw.w)};
            const f32x4 a = (f32x4){cur[0], cur[1], cur[2], cur[3]}, b = (f32x4){cur[4], cur[5], cur[6], cur[7]};
            float y[8];
#pragma unroll
            for (int e = 0; e < 8; ++e) { y[e] = bb[e] + w[0][e] * h[0][e] + w[1][e] * h[1][e] + w[2][e] * h[2][e] + w[3][e] * cur[e]; h[0][e] = h[1][e]; h[1][e] = h[2][e]; h[2][e] = cur[e]; }
            u32x4 o; o.x = cvt_pk_bf16(y[0], y[1]); o.y = cvt_pk_bf16(y[2], y[3]); o.z = cvt_pk_bf16(y[4], y[5]); o.w = cvt_pk_bf16(y[6], y[7]);
            *(u32x4*)(XC + (size_t)(r0 + i) * D + c8) = o;
            if (tail && i >= 5) { *(f32x4*)(so + (size_t)(i - 5) * D) = a; *(f32x4*)(so + (size_t)(i - 5) * D + 4) = b; }
        }
    }
}

__device__ __forceinline__ void phase_scan1(const Params& P, int wv) {
    const int tid = opaque_tid(wv), ch = tid * 2;
    const _Float16* LA = (const _Float16*)(P.ws + WS_MIX + MIX_XR); const _Float16* U = (const _Float16*)(P.ws + WS_MIX + MIX_U);
    float* CS = (float*)(P.ws + WS_CARRY); float* CH = CS + 256 * 1024;
    for (int u = opaque_s((int)blockIdx.x); u < 256; u += opaque_s((int)gridDim.x)) {
        const size_t base = (size_t)u * 64 * D + ch;
        float s0 = 0.f, s1 = 0.f, h0 = 0.f, h1 = 0.f;
#pragma unroll 8
        for (int t = 0; t < 64; ++t) {
            const h16x2 la = *(const h16x2*)(LA + base + (size_t)t * D), uu = *(const h16x2*)(U + base + (size_t)t * D);
            const float l0 = (float)la.x, l1 = (float)la.y;
            h0 = __expf(l0) * h0 + (float)uu.x; h1 = __expf(l1) * h1 + (float)uu.y; s0 += l0; s1 += l1;
        }
        *(f32x2*)(CS + (size_t)u * D + ch) = (f32x2){s0, s1}; *(f32x2*)(CH + (size_t)u * D + ch) = (f32x2){h0, h1};
    }
}
__device__ __forceinline__ void phase_scan3(const Params& P, int l, int wv) {
    const int tid = opaque_tid(wv), ch = tid * 2;
    const _Float16* LA = (const _Float16*)(P.ws + WS_MIX + MIX_XR); const _Float16* U = (const _Float16*)(P.ws + WS_MIX + MIX_U);
    const bf16_t* GG = (const bf16_t*)(P.ws + WS_MIX + MIX_GG); bf16_t* HG = (bf16_t*)(P.ws + WS_MIX + MIX_XC);
    const float* CS = (const float*)(P.ws + WS_CARRY); const float* CH = CS + 256 * 1024;
    for (int u = opaque_s((int)blockIdx.x); u < 256 + 16; u += opaque_s((int)gridDim.x)) {
        if (u < 256) {
            const int b = u >> 6, c = u & 63;
            float h0 = 0.f, h1 = 0.f;
#pragma unroll 8
            for (int cc = 0; cc < c; ++cc) {
                const f32x2 s = *(const f32x2*)(CS + (size_t)(b * 64 + cc) * D + ch), hh = *(const f32x2*)(CH + (size_t)(b * 64 + cc) * D + ch);
                h0 = __expf(s.x) * h0 + hh.x; h1 = __expf(s.y) * h1 + hh.y;
            }
            const size_t base = (size_t)u * 64 * D + ch;
#pragma unroll 1
            for (int tb = 0; tb < 64; tb += 8) {
                h16x2 la[8], uu[8]; unsigned g[8], hg[8];
#pragma unroll
                for (int t = 0; t < 8; ++t) { const size_t o = base + (size_t)(tb + t) * D; la[t] = *(const h16x2*)(LA + o); uu[t] = *(const h16x2*)(U + o); g[t] = *(const unsigned*)(GG + o); }
#pragma unroll
                for (int t = 0; t < 8; ++t) { h0 = __expf((float)la[t].x) * h0 + (float)uu[t].x; h1 = __expf((float)la[t].y) * h1 + (float)uu[t].y; hg[t] = cvt_pk_bf16(h0 * bf_lo(g[t]), h1 * bf_hi(g[t])); }
#pragma unroll
                for (int t = 0; t < 8; ++t) *(unsigned*)(HG + base + (size_t)(tb + t) * D) = hg[t];
            }
            if (c == 63) *(f32x2*)(P.out + O_PH + ((size_t)l * NSEQ + b) * D + ch) = (f32x2){h0, h1};
        } else {
            const int v = u - 256;
            for (int q = 0; q < 8; ++q) {
                const int s = v * 8 + q;
                const f32x2 hi = *(const f32x2*)(P.in[2] + ((size_t)l * DB + s) * D + ch);
                float h0 = hi.x, h1 = hi.y;
                const size_t base = (size_t)(MP + s * 8) * D + ch;
                h16x2 la[8], uu[8]; unsigned g[8], hg[8];
#pragma unroll
                for (int t = 0; t < 8; ++t) { const size_t o = base + (size_t)t * D; la[t] = *(const h16x2*)(LA + o); uu[t] = *(const h16x2*)(U + o); g[t] = *(const unsigned*)(GG + o); }
#pragma unroll
                for (int t = 0; t < 8; ++t) { h0 = __expf((float)la[t].x) * h0 + (float)uu[t].x; h1 = __expf((float)la[t].y) * h1 + (float)uu[t].y; hg[t] = cvt_pk_bf16(h0 * bf_lo(g[t]), h1 * bf_hi(g[t])); }
#pragma unroll
                for (int t = 0; t < 8; ++t) *(unsigned*)(HG + base + (size_t)t * D) = hg[t];
                *(f32x2*)(P.out + O_SH + ((size_t)l * DB + s) * D + ch) = (f32x2){h0, h1};
            }
        }
    }
}

constexpr int KROW = 144;
constexpr int VROW = 560;
constexpr int KS_BYTES = 272 * KROW, VT_OFF = KS_BYTES;
__device__ __forceinline__ void attn_tile(LAS const unsigned char* Ks, LAS const unsigned char* Vt, int kt0, const bf16_t* qptr, bf16_t* optr,
                                          float slope, float sink, int diff0, int dmax, int lane) {
    const int j = lane & 15, g = lane >> 4;
    bf16x8 qf[2];
    qf[0] = *(const bf16x8*)(qptr + g * 8); qf[1] = *(const bf16x8*)(qptr + 32 + g * 8);
    f32x4 s[10];
#pragma unroll
    for (int kt = 0; kt < 10; ++kt) {
        f32x4 a = (f32x4){0.f, 0.f, 0.f, 0.f};
#pragma unroll
        for (int ks = 0; ks < 2; ++ks) {
            const bf16x8 kf = *(LAS const bf16x8*)(Ks + ((kt0 + kt) * 16 + j) * KROW + (ks * 32 + g * 8) * 2);
            a = __builtin_amdgcn_mfma_f32_16x16x32_bf16(kf, qf[ks], a, 0, 0, 0);
        }
        s[kt] = a;
        if (kt & 1) __builtin_amdgcn_sched_barrier(0);
    }
    float mx = sink;
#pragma unroll
    for (int kt = 0; kt < 10; ++kt)
#pragma unroll
        for (int r = 0; r < 4; ++r) {
            const int diff = diff0 - kt * 16 - r; const bool ok = (diff >= 0) && (diff <= dmax);
            const float v = ok ? s[kt][r] - slope * (float)diff : -1e30f; s[kt][r] = v; mx = fmaxf(mx, v);
        }
    mx = fmaxf(mx, __shfl_xor(mx, 16)); mx = fmaxf(mx, __shfl_xor(mx, 32));
    float sum = 0.f;
#pragma unroll
    for (int kt = 0; kt < 10; ++kt)
#pragma unroll
        for (int r = 0; r < 4; ++r) { const float p = __expf(s[kt][r] - mx); s[kt][r] = p; sum += p; }
    sum += __shfl_xor(sum, 16); sum += __shfl_xor(sum, 32);
    sum += __expf(sink - mx);
    const float inv = 1.f / sum;
    f32x4 o[4];
#pragma unroll
    for (int dt = 0; dt < 4; ++dt) o[dt] = (f32x4){0.f, 0.f, 0.f, 0.f};
#pragma unroll
    for (int kp = 0; kp < 5; ++kp) {
        union { u32x4 u; bf16x8 b; } pf;
        pf.u.x = cvt_pk_bf16(s[2 * kp][0], s[2 * kp][1]); pf.u.y = cvt_pk_bf16(s[2 * kp][2], s[2 * kp][3]);
        pf.u.z = cvt_pk_bf16(s[2 * kp + 1][0], s[2 * kp + 1][1]); pf.u.w = cvt_pk_bf16(s[2 * kp + 1][2], s[2 * kp + 1][3]);
#pragma unroll
        for (int dt = 0; dt < 4; ++dt) {
            LAS const unsigned char* vr = Vt + (dt * 16 + j) * VROW + ((kt0 + 2 * kp) * 16 + g * 4) * 2;
            const u32x2 lo = *(LAS const u32x2*)vr, hi = *(LAS const u32x2*)(vr + 32);
            union { u32x4 u; bf16x8 b; } vf; vf.u.x = lo.x; vf.u.y = lo.y; vf.u.z = hi.x; vf.u.w = hi.y;
            o[dt] = __builtin_amdgcn_mfma_f32_16x16x32_bf16(vf.b, pf.b, o[dt], 0, 0, 0);
        }
        __builtin_amdgcn_sched_barrier(0);
    }
#pragma unroll
    for (int dt = 0; dt < 4; ++dt) {
        u32x2 w; w.x = cvt_pk_bf16(o[dt].x * inv, o[dt].y * inv); w.y = cvt_pk_bf16(o[dt].z * inv, o[dt].w * inv);
        *(u32x2*)(optr + dt * 16 + g * 4) = w;
    }
}

__device__ __forceinline__ void phase_attn(const Params& P, int j, LAS unsigned char* lds, int wv) {
    const int tid = opaque_tid(wv), lane = tid & 63, wave = __builtin_amdgcn_readfirstlane(tid >> 6);
    unsigned char* ws = opaque_p(P.ws);
    const bf16_t* KVB = (const bf16_t*)(ws + WS_KVB); const bf16_t* Q = (const bf16_t*)(ws + WS_MIX + MIX_GG); bf16_t* O = (bf16_t*)(ws + WS_MIX + MIX_XR);
    const float* sinks = opaque_p(opaque_p(P.in[25]) + opaque_s(j) * 16); const bf16_t* CKB = (const bf16_t*)(ws + WS_CKB);
    LAS unsigned char* Ks = lds; LAS unsigned char* Vt = lds + VT_OFF;
    for (int u = opaque_s((int)blockIdx.x); u < 512; u += opaque_s((int)gridDim.x)) {
        __syncthreads();
        if (u < 256) {
            const int b = u >> 6, qb = (u >> 1) & 31, kh = u & 1;
            const int pos0 = qb * 128 - 144;
#pragma unroll 2
            for (int idx = tid; idx < 272 * 8; idx += NTHR) {
                const int i = idx >> 3, c = idx & 7, pos = pos0 + i;
                u32x4 kv = (u32x4){0u, 0u, 0u, 0u}, vv = kv;
                if (pos >= 0) { const bf16_t* r = KVB + (size_t)(b * SEQ + pos) * 256 + kh * 64 + c * 8; kv = *(const u32x4*)r; vv = *(const u32x4*)(r + 128); }
                *(LAS u32x4*)(Ks + i * KROW + c * 16) = kv;
                LAS unsigned short* vt = (LAS unsigned short*)(Vt + (c * 8) * VROW + i * 2);
                vt[0 * (VROW / 2)] = (unsigned short)(vv.x & 0xffff); vt[1 * (VROW / 2)] = (unsigned short)(vv.x >> 16);
                vt[2 * (VROW / 2)] = (unsigned short)(vv.y & 0xffff); vt[3 * (VROW / 2)] = (unsigned short)(vv.y >> 16);
                vt[4 * (VROW / 2)] = (unsigned short)(vv.z & 0xffff); vt[5 * (VROW / 2)] = (unsigned short)(vv.z >> 16);
                vt[6 * (VROW / 2)] = (unsigned short)(vv.w & 0xffff); vt[7 * (VROW / 2)] = (unsigned short)(vv.w >> 16);
            }
            __syncthreads();
            const int h = kh * 8 + wave; const float slope = exp2f(-0.5f * (float)(h + 1)), sink = sinks[h];
            const int jq = lane & 15, g = lane >> 4;
#pragma unroll 1
            for (int qt = 0; qt < 8; ++qt) {
                const int q0 = qb * 128 + qt * 16, qpos = q0 + jq; const size_t row = (size_t)b * SEQ + qpos;
                attn_tile(Ks, Vt, qt, Q + row * D + h * 64, O + row * D + h * 64, slope, sink, 144 + jq - 4 * g, qpos < 127 ? qpos : 127, lane);
            }
        } else {
            const int v = u - 256, s = v >> 1, kh = v & 1;
#pragma unroll 1
            for (int idx = tid; idx < 160 * 8; idx += NTHR) {
                const int i = idx >> 3, c = idx & 7;
                u32x4 kv = (u32x4){0u, 0u, 0u, 0u}, vv = kv;
                if (i < 128) {
                    const bf16_t* kr = CKB + (((size_t)s * 128 + i) * 2 + kh) * 64 + c * 8;
                    kv = *(const u32x4*)kr; vv = *(const u32x4*)(kr + (size_t)DB * 16384);
                } else if (i < 136) { const bf16_t* r = KVB + (size_t)(MP + s * 8 + (i - 128)) * 256 + kh * 64 + c * 8; kv = *(const u32x4*)r; vv = *(const u32x4*)(r + 128); }
                *(LAS u32x4*)(Ks + i * KROW + c * 16) = kv;
                LAS unsigned short* vt = (LAS unsigned short*)(Vt + (c * 8) * VROW + i * 2);
                vt[0 * (VROW / 2)] = (unsigned short)(vv.x & 0xffff); vt[1 * (VROW / 2)] = (unsigned short)(vv.x >> 16);
                vt[2 * (VROW / 2)] = (unsigned short)(vv.y & 0xffff); vt[3 * (VROW / 2)] = (unsigned short)(vv.y >> 16);
                vt[4 * (VROW / 2)] = (unsigned short)(vv.z & 0xffff); vt[5 * (VROW / 2)] = (unsigned short)(vv.z >> 16);
                vt[6 * (VROW / 2)] = (unsigned short)(vv.w & 0xffff); vt[7 * (VROW / 2)] = (unsigned short)(vv.w >> 16);
            }
            __syncthreads();
            if (wave < 4) {
                const int jq = lane & 15, g = lane >> 4, h = kh * 8 + wave * 2 + (jq >> 3), i = jq & 7;
                const float slope = exp2f(-0.5f * (float)(h + 1)), sink = sinks[h];
                const size_t row = (size_t)MP + s * 8 + i;
                attn_tile(Ks, Vt, 0, Q + row * D + h * 64, O + row * D + h * 64, slope, sink, 128 + i - 4 * g, 127, lane);
            }
        }
    }
    __syncthreads();
}

constexpr size_t MIX_PART = 100663296;
__device__ __forceinline__ void phase_reduce(const Params& P, int nres_next, int wv) {
    const int tid = opaque_tid(wv), lane = tid & 63, wave = tid >> 6;
    unsigned char* ws = opaque_p(P.ws);
    float* X = opaque_p(P.out) + O_X; bf16_t* XB = (bf16_t*)(ws + WS_XB); float* SSn = (float*)(ws + WS_SSP) + (size_t)nres_next * M * 16;
    const float* PART = (const float*)(ws + WS_MIX + MIX_PART);
    for (int r = opaque_s((int)blockIdx.x) * 8 + wave; r < MS; r += opaque_s((int)gridDim.x) * 8) {
        const int row = MP + r; float s = 0.f;
        u32x2 o[4]; f32x4 a[4];
#pragma unroll
        for (int j = 0; j < 4; ++j) {
            const size_t c = (size_t)j * 256 + lane * 4;
            o[j] = *(const u32x2*)(XB + (size_t)row * D + c);
            a[j] = *(const f32x4*)(PART + (size_t)r * D + c);
#pragma unroll
            for (int kc = 1; kc < 6; ++kc) a[j] = a[j] + *(const f32x4*)(PART + ((size_t)kc * MS + r) * D + c);
        }
#pragma unroll
        for (int j = 0; j < 4; ++j) {
            const size_t c = (size_t)j * 256 + lane * 4;
            f32x4 v = (f32x4){bf_lo(o[j].x), bf_hi(o[j].x), bf_lo(o[j].y), bf_hi(o[j].y)}; v = v + a[j] * 0.5f;
            u32x2 w; w.x = cvt_pk_bf16(v.x, v.y); w.y = cvt_pk_bf16(v.z, v.w);
            *(u32x2*)(XB + (size_t)row * D + c) = w;
            v = (f32x4){bf_lo(w.x), bf_hi(w.x), bf_lo(w.y), bf_hi(w.y)};
            s += (v.x * v.x + v.y * v.y) + (v.z * v.z + v.w * v.w);
        }
#pragma unroll
        for (int o2 = 1; o2 < 64; o2 <<= 1) s += __shfl_xor(s, o2);
        if (lane < 16) SSn[(size_t)row * 16 + lane] = lane == 0 ? s : 0.f;
    }
}

__device__ __forceinline__ void phase_final(const Params& P, int wv) {
    const int tid = opaque_tid(wv), lane = tid & 63, wave = tid >> 6;
    float* X = P.out + O_X; const bf16_t* XB = (const bf16_t*)(P.ws + WS_XB); const float* ss = (const float*)(P.ws + WS_SSP) + 12 * (size_t)M * 16; const float* g = P.in[27];
    f32x4 gv[4];
#pragma unroll
    for (int j = 0; j < 4; ++j) gv[j] = *(const f32x4*)(g + j * 256 + lane * 4);
    const int nwv = opaque_s((int)gridDim.x) * 8;
    for (int row = opaque_s((int)blockIdx.x) * 8 + wave; row < M; row += 2 * nwv) {
        const int row2 = row + nwv; const bool has2 = row2 < M; const int r2 = has2 ? row2 : row;
        const float rs = rstd_of(ss, row), rs2 = rstd_of(ss, r2);
        u32x2 o[4], o2[4];
#pragma unroll
        for (int j = 0; j < 4; ++j) { o[j] = *(const u32x2*)(XB + (size_t)row * D + j * 256 + lane * 4); o2[j] = *(const u32x2*)(XB + (size_t)r2 * D + j * 256 + lane * 4); }
#pragma unroll
        for (int j = 0; j < 4; ++j) {
            const f32x4 v = (f32x4){bf_lo(o[j].x), bf_hi(o[j].x), bf_lo(o[j].y), bf_hi(o[j].y)}; *(f32x4*)(X + (size_t)row * D + j * 256 + lane * 4) = v * rs * gv[j];
            if (has2) { const f32x4 v2 = (f32x4){bf_lo(o2[j].x), bf_hi(o2[j].x), bf_lo(o2[j].y), bf_hi(o2[j].y)}; *(f32x4*)(X + (size_t)row2 * D + j * 256 + lane * 4) = v2 * rs2 * gv[j]; }
        }
    }
}

#define XB_TMO      128
#define XB_XCNT(j)  (256  + 64 * (j))
#define XB_XSUB(j)  (1280 + 64 * (j))
#define XB_XGEN(j)  (2304 + 64 * (j))
#define XB_TOP      3328
#define XB_TOPGEN   3392
#define XCD_BAR_WORDS 3456
#define XB_SPIN_CAP (1u << 20)
__device__ __forceinline__ unsigned xb_ld(unsigned* p)              { return __hip_atomic_load(p, __ATOMIC_RELAXED, __HIP_MEMORY_SCOPE_AGENT); }
__device__ __forceinline__ unsigned xb_add(unsigned* p, unsigned v) { return __hip_atomic_fetch_add(p, v, __ATOMIC_RELAXED, __HIP_MEMORY_SCOPE_AGENT); }
__device__ __forceinline__ unsigned xb_xcc_id() { return (unsigned)__builtin_amdgcn_s_getreg((3 << 11) | 20) & 0xFu; }
#define XB_SPIN(cond, bar) do { unsigned _sp = 0; while (cond) { __builtin_amdgcn_s_sleep(1); \
    if ((++_sp & 255u) == 0u) { if (xb_ld(&(bar)[XB_TMO])) break; if (_sp > XB_SPIN_CAP) { atomicAdd(&(bar)[XB_TMO], 1u); break; } } } } while (0)
struct XcdBarrier { unsigned* bar; unsigned x; volatile LAS unsigned* st; };
__device__ __forceinline__ XcdBarrier xcd_barrier_post(unsigned* bar, volatile LAS unsigned* st) {
    XcdBarrier b; b.bar = bar; b.x = xb_xcc_id(); b.st = st;
    if (threadIdx.x == 0) (void)xb_add(&bar[XB_XCNT(b.x)], 1u);
    return b;
}
__device__ __forceinline__ void xcd_barrier_complete(unsigned* bar, unsigned x, unsigned& nloc, unsigned& nx) {
    const unsigned G = gridDim.x * gridDim.y * gridDim.z;
    unsigned sum, cnt, mine, sp = 0u;
    for (;;) {
        sum = 0u; cnt = 0u; mine = 0u;
#pragma unroll
        for (unsigned j = 0; j < 16; ++j) { const unsigned c = xb_ld(&bar[XB_XCNT(j)]); sum += c; cnt += (c > 0u) ? 1u : 0u; mine = (j == x) ? c : mine; }
        if (sum == G) break;
        __builtin_amdgcn_s_sleep(1);
        if ((++sp & 255u) == 0u) { if (xb_ld(&bar[XB_TMO])) break; if (sp > XB_SPIN_CAP) { atomicAdd(&bar[XB_TMO], 1u); break; } }
    }
    nloc = mine > 0u ? mine : 1u; nx = cnt > 0u ? cnt : 1u;
}
__device__ __forceinline__ void xcd_barrier(unsigned* bar, unsigned x, volatile LAS unsigned* st, int wv) {
    asm volatile("s_waitcnt vmcnt(0)" ::: "memory");
    __syncthreads();
    if (opaque_tid(wv) == 0) {
        __builtin_amdgcn_s_waitcnt(0);
        unsigned nloc = st[0], nx = st[1];
        if (nloc == 0u) { xcd_barrier_complete(bar, x, nloc, nx); st[0] = nloc; st[1] = nx; }
        const unsigned old = xb_add(&bar[XB_XSUB(x)], 1u);
        const unsigned gen = old / nloc;
        if (old + 1u == (gen + 1u) * nloc) {
            __builtin_amdgcn_fence(__ATOMIC_RELEASE, "agent");
            asm volatile("s_waitcnt vmcnt(0)" ::: "memory");
            asm volatile("buffer_inv sc1" ::: "memory");
            const unsigned og = xb_add(&bar[XB_TOP], 1u);
            const unsigned tg = og / nx;
            if (og + 1u == (tg + 1u) * nx) {
#pragma unroll
                for (unsigned j = 0; j < 16; ++j) xb_add(&bar[XB_XGEN(j)], 1u);
            } else XB_SPIN(xb_ld(&bar[XB_XGEN(x)]) == gen, bar);
            asm volatile("s_waitcnt vmcnt(0)" ::: "memory");
        } else {
            asm volatile("buffer_inv sc1" ::: "memory");
            XB_SPIN(xb_ld(&bar[XB_XGEN(x)]) == gen, bar);
            asm volatile("s_waitcnt vmcnt(0)" ::: "memory");
        }
    }
    __syncthreads();
}

constexpr int N_PHASES = 45;
constexpr int LDS_BYTES = 131072 + 64 + 1024;
__global__ void __launch_bounds__(NTHR, 2) yoco_fwd(Params P) {
    extern __shared__ __attribute__((aligned(16))) unsigned char lds_raw[];
    LAS unsigned char* lds = (LAS unsigned char*)lds_raw;
    cg::grid_group grid = cg::this_grid();
    const int wv = __builtin_amdgcn_readfirstlane((int)(threadIdx.x >> 6));
    int ph = 0, nres = 0;
    volatile LAS unsigned* bst = (volatile LAS unsigned*)(lds + 131072);
    if (threadIdx.x < 16) bst[threadIdx.x] = 0u;
    __syncthreads();
    unsigned* barw = (unsigned*)(P.ws + WS_BAR);
    const unsigned xcc = P.hi - P.lo > 1 ? xcd_barrier_post(barw, bst).x : 0u;
    if (P.hi > 100000) grid.sync();
#define ON() (ph >= P.lo && ph < P.hi)
#define PV() const int G = opaque_s((int)gridDim.x), bid = opaque_s((int)blockIdx.x); unsigned char* ws = opaque_p(P.ws); float* X = opaque_p(P.out); bf16_t* XB = (bf16_t*)(ws + WS_XB); float* SS = (float*)(ws + WS_SSP); \
    bf16_t* W = (bf16_t*)(ws + WS_W); unsigned char* MIX = ws + WS_MIX; (void)G; (void)bid; (void)X; (void)XB; (void)SS; (void)W; (void)MIX
#define SEAM() do { if (ph >= P.lo && ph + 1 < P.hi) xcd_barrier(opaque_p(barw), opaque_s((int)xcc), bst, wv); ++ph; } while (0)

    if (ON()) phase_prep(P, lds, wv);
    SEAM();
    for (int l = 0; l < 4; ++l) {
        for (int f = 0; f < 2; ++f) {
            if (f == 1) {
                if (l < 2) {
                    if (ON()) { PV(); pg8::Gemm g{XB, W + W_IN + (size_t)l * 2048 * D, D, D, D, M / 256, 8, 0}; pg8::StaticOrder S; S.init(M / 256, 8, G, bid);
                        EpiRgIn E{(bf16_t*)(MIX + MIX_GG), (bf16_t*)(MIX + MIX_XR), SS + (size_t)nres * M * 16, (LAS float*)(lds + RS_OFF)}; pg8::gemm_phase(lds, g, S, E, wv); }
                    SEAM();
                    if (ON()) phase_conv(P, l, wv);
                    SEAM();
                    if (ON()) { PV(); pg8::Gemm g{(const bf16_t*)(MIX + MIX_XC), W + W_G + (size_t)l * 2048 * 256, D, 256, 256, M / 256, 8, 1}; pg8::StaticOrder S; S.init(M / 256, 8, G, bid);
                        EpiGates E{MIX, (const float*)(ws + WS_SPT) + l * 3 * D}; pg8::gemm_phase(lds, g, S, E, wv); }
                    SEAM();
                    if (ON()) phase_scan1(P, wv);
                    SEAM();
                    if (ON()) phase_scan3(P, l, wv);
                    SEAM();
                    if (ON()) { PV(); pg8::Gemm g{(const bf16_t*)(MIX + MIX_XC), W + W_OUT + (size_t)l * D * D, D, D, D, M / 256, 4, 0}; pg8::StaticOrder S; S.init(M / 256, 4, G, bid);
                        EpiResid E{X, XB, SS + (size_t)(nres + 1) * M * 16, 1.f, nullptr}; pg8::gemm_phase(lds, g, S, E, wv); }
                    SEAM(); ++nres;
                } else {
                    const int j = opaque_s(opaque_s(l) - 2);
                    if (ON()) { PV(); pg8::Gemm g{XB, W + W_Q + (size_t)j * D * D, D, D, D, M / 256, 4, 0}; pg8::StaticOrder S; S.init(M / 256, 4, G, bid);
                        EpiQ E{(bf16_t*)(MIX + MIX_GG), SS + (size_t)nres * M * 16, (LAS float*)(lds + RS_OFF)}; pg8::gemm_phase(lds, g, S, E, wv); }
                    SEAM();
                    if (ON()) phase_attn(P, j, lds, wv);
                    SEAM();
                    if (ON()) { PV(); pg8::Gemm g{(const bf16_t*)(MIX + MIX_XR), W + W_O + (size_t)j * D * D, D, D, D, M / 256, 4, 0}; pg8::StaticOrder S; S.init(M / 256, 4, G, bid);
                        EpiResid E{X, XB, SS + (size_t)(nres + 1) * M * 16, 1.f, nullptr}; pg8::gemm_phase(lds, g, S, E, wv); }
                    SEAM(); ++nres;
                }
            }
            if (ON()) { PV(); pg8::Gemm g{XB, W + W_GU + (size_t)(l * 2 + f) * NGU * D, D, D, D, M / 256, NGU / 256, 0}; pg8::StaticOrder S; S.init(M / 256, NGU / 256, G, bid);
                EpiSwiGLU E{(bf16_t*)(MIX + MIX_GG), SS + (size_t)nres * M * 16, (LAS float*)(lds + RS_OFF)}; pg8::gemm_phase(lds, g, S, E, wv); }
            SEAM();
            if (ON()) { PV(); pg8::Gemm g{(const bf16_t*)(MIX + MIX_GG), W + W_D + (size_t)(l * 2 + f) * D * DFF, DFF, DFF, DFF, M / 256, 4, 0}; pg8::DownOrder S; S.init(G, bid);
                EpiResid E{X, XB, SS + (size_t)(nres + 1) * M * 16, 0.5f, (float*)(MIX + MIX_PART)}; pg8::gemm_phase(lds, g, S, E, wv); }
            SEAM();
            if (ON()) phase_reduce(P, nres + 1, wv);
            SEAM(); ++nres;
        }
        if (l == 1) {
            if (ON()) { PV(); pg8::Gemm g{XB, W + W_KV, D, D, D, M / 256, 1, 0}; pg8::StaticOrder S; S.init(M / 256, 1, G, bid);
                EpiKV E{(bf16_t*)(ws + WS_KVB), X, SS + (size_t)nres * M * 16, (LAS float*)(lds + RS_OFF)}; pg8::gemm_phase(lds, g, S, E, wv); }
            SEAM();
        }
    }
    if (ON()) phase_final(P, wv);
#undef ON
#undef SEAM
}

extern "C" void kernel_launch(void* const* d_in, const int* in_sizes, int n_in, void* d_out, int out_size, void* d_ws, size_t ws_size, hipStream_t stream) {
    static int grid = 0;
    if (grid == 0) {
        if (n_in != 28 || (size_t)out_size != OUT_TOTAL || ws_size < WS_END) { fprintf(stderr, "kernel_launch: unexpected shapes (n_in %d out %d ws %zu need %zu)\n", n_in, out_size, ws_size, (size_t)WS_END); grid = -1; return; }
        int dev = 0, cus = 0, per_cu = 0;
        hipGetDevice(&dev); hipDeviceGetAttribute(&cus, hipDeviceAttributeMultiprocessorCount, dev);
        if (hipFuncSetAttribute((const void*)yoco_fwd, hipFuncAttributeMaxDynamicSharedMemorySize, LDS_BYTES) != hipSuccess) { fprintf(stderr, "kernel_launch: hipFuncSetAttribute failed\n"); grid = -1; return; }
        hipOccupancyMaxActiveBlocksPerMultiprocessor(&per_cu, (const void*)yoco_fwd, NTHR, LDS_BYTES);
        (void)hipGetLastError();
        if (per_cu < 1) per_cu = 1;
        grid = cus;
        fprintf(stderr, "kernel_launch: cus %d per_cu %d grid %d\n", cus, per_cu, grid);
    }
    if (grid < 0) return;
    if (hipMemsetAsync((char*)d_ws + WS_BAR, 0, 16384, stream) != hipSuccess) { fprintf(stderr, "kernel_launch: memset failed\n"); return; }
    Params p{};
    for (int i = 0; i < 28; ++i) p.in[i] = (const float*)d_in[i];
    p.out = (float*)d_out; p.ws = (unsigned char*)d_ws;
#if N_LAUNCH_MODE == 1
#ifndef DBG_LAST_PHASE
#define DBG_LAST_PHASE (N_PHASES - 1)
#endif
    for (int i = 0; i < N_PHASES; ++i) { if (i > DBG_LAST_PHASE && i != N_PHASES - 1) continue; p.lo = i; p.hi = i + 1; hipLaunchKernelGGL(yoco_fwd, dim3(grid), dim3(NTHR), LDS_BYTES, stream, p); }
#else
    p.lo = 0; p.hi = N_PHASES;
    void* args[] = {&p};
    hipError_t e = hipLaunchCooperativeKernel((const void*)yoco_fwd, dim3(grid), dim3(NTHR), args, LDS_BYTES, stream);
    if (e != hipSuccess) fprintf(stderr, "cooperative launch failed: %s (grid %d)\n", hipGetErrorString(e), grid);
#endif
}
```

```cpp
#include <hip/hip_runtime.h>
#include <hip/hip_cooperative_groups.h>
#include <cstdio>
#include <cstdint>
namespace cg = cooperative_groups;

#ifndef N_LAUNCH_MODE
#define N_LAUNCH_MODE 0
#endif

#define LAS __attribute__((address_space(3)))
#define GAS __attribute__((address_space(1)))
typedef unsigned short bf16_t;
typedef short bf16x8 __attribute__((ext_vector_type(8)));
typedef float f32x4 __attribute__((ext_vector_type(4)));
typedef float f32x2 __attribute__((ext_vector_type(2)));
typedef unsigned u32x4 __attribute__((ext_vector_type(4)));
typedef unsigned u32x2 __attribute__((ext_vector_type(2)));
typedef _Float16 h16x8 __attribute__((ext_vector_type(8)));
typedef _Float16 h16x2 __attribute__((ext_vector_type(2)));

constexpr int D = 1024, DFF = 2816, NGU = 5632;
constexpr int MP = 16384, MS = 1024, M = MP + MS;
constexpr int SEQ = 4096, NSEQ = 4, DB = 128, DS = 8;
constexpr int NTHR = 512;
constexpr float EPS = 1e-6f;

constexpr size_t O_X = 0;
constexpr size_t O_PH = 17825792, O_PC = O_PH + 8192, O_PK = O_PC + 24576, O_PV = O_PK + 65536;
constexpr size_t O_SH = O_PV + 65536, O_SC = O_SH + 262144, O_SK = O_SC + 786432, O_SV = O_SK + 2097152;
constexpr size_t OUT_TOTAL = O_SV + 2097152;

constexpr size_t WS_SS = 0;
constexpr size_t WS_SPT = 917504;
constexpr size_t WS_CARRY = 1048576;
constexpr size_t WS_KVB = WS_CARRY + 2097152;
constexpr size_t WS_XB = WS_KVB + (size_t)M * 256 * 2;
constexpr size_t WS_MIX = WS_XB + (size_t)M * D * 2;
constexpr size_t MIX_GG = 0;
constexpr size_t MIX_XR = (size_t)M * D * 2;
constexpr size_t MIX_U = MIX_XR + (size_t)M * D * 2;
constexpr size_t MIX_XC = MIX_XR + (size_t)M * D * 4;
constexpr size_t MIX_BYTES = MIX_XC + (size_t)M * D * 2;
constexpr size_t WS_W = WS_MIX + MIX_BYTES;
constexpr size_t W_GU = 0, W_D = W_GU + 8ull * NGU * D, W_IN = W_D + 8ull * D * DFF, W_OUT = W_IN + 2ull * 2048 * D;
constexpr size_t W_KV = W_OUT + 2ull * D * D, W_Q = W_KV + 256ull * D, W_O = W_Q + 2ull * D * D, W_G = W_O + 2ull * D * D;
constexpr size_t W_END = W_G + 2ull * 2048 * 256;
constexpr size_t WS_SSP = WS_W + W_END * 2;
constexpr size_t WS_CKB = WS_SSP + 13ull * M * 16 * 4;
constexpr size_t WS_BAR = WS_CKB + 2ull * DB * 128 * 128 * 2;
constexpr size_t WS_END = WS_BAR + 16384;

struct Params { const float* in[28]; float* out; unsigned char* ws; int lo, hi; };

__device__ __forceinline__ unsigned cvt_pk_bf16(float lo, float hi) { unsigned r; asm volatile("v_cvt_pk_bf16_f32 %0, %1, %2" : "=v"(r) : "v"(lo), "v"(hi)); return r; }
__device__ __forceinline__ void st16_wt(void* p, u32x4 v) { asm volatile("global_store_dwordx4 %0, %1, off sc1\n\ts_nop 1" :: "v"(p), "v"(v) : "memory"); }
__device__ __forceinline__ float bf_lo(unsigned w) { return __uint_as_float(w << 16); }
__device__ __forceinline__ float bf_hi(unsigned w) { return __uint_as_float(w & 0xffff0000u); }
__device__ __forceinline__ float fast_rcp(float x) { return __builtin_amdgcn_rcpf(x); }
__device__ __forceinline__ float sigmoidf_(float x) { return fast_rcp(1.f + __expf(-x)); }
__device__ __forceinline__ float silu_(float x) { return x * sigmoidf_(x); }
__device__ __forceinline__ float gelu_tanh_(float x) { return x * sigmoidf_(1.5957691216f * (x + 0.044715f * x * x * x)); }
__device__ __forceinline__ float rstd_of(const float* ssp, int row) { const GAS f32x4* p = (const GAS f32x4*)(ssp + (size_t)row * 16); const f32x4 a = p[0], b = p[1], c = p[2], d = p[3];
    const float ss = ((a.x + a.y) + (a.z + a.w)) + ((b.x + b.y) + (b.z + b.w)) + ((c.x + c.y) + (c.z + c.w)) + ((d.x + d.y) + (d.z + d.w)); return rsqrtf(ss * (1.f / D) + EPS); }
constexpr int RS_OFF = 131072 + 64;
#define GASP __attribute__((address_space(1)))
__device__ __forceinline__ void rstd_prefetch(f32x4 (&pf)[4], const float* ssp, int pm, int tid) {
    if (tid < 256) { const GASP f32x4* p = (const GASP f32x4*)(ssp + (size_t)(pm * 256 + tid) * 16); pf[0] = p[0]; pf[1] = p[1]; pf[2] = p[2]; pf[3] = p[3]; }
}
__device__ __forceinline__ void unit_rstd(const f32x4 (&pf)[4], LAS float* rsl, int tid) {
    if (tid < 256) { const f32x4 a = pf[0], b = pf[1], c = pf[2], d = pf[3];
        const float ss = ((a.x + a.y) + (a.z + a.w)) + ((b.x + b.y) + (b.z + b.w)) + ((c.x + c.y) + (c.z + c.w)) + ((d.x + d.y) + (d.z + d.w)); rsl[tid] = rsqrtf(ss * (1.f / D) + EPS); }
    asm volatile("s_waitcnt lgkmcnt(0)" ::: "memory"); __builtin_amdgcn_s_barrier(); asm volatile("" ::: "memory");
}
__device__ __forceinline__ int opaque_s(int x) { asm volatile("" : "+s"(x)); return x; }
template <class T> __device__ __forceinline__ T* opaque_p(T* p) { asm volatile("" : "+s"(p)); return p; }
__device__ __forceinline__ int opaque_tid(int wv) { unsigned z = 0u; asm volatile("" : "+s"(z)); int t = opaque_s(wv) * 64 + (int)__builtin_amdgcn_mbcnt_hi(~0u, __builtin_amdgcn_mbcnt_lo(~0u, z)); asm volatile("" : "+v"(t)); return t; }

namespace pg8 {
constexpr int BM = 256, BK = 64, HALF = 128, HTB = HALF * BK * 2, STAGE_BYTES = 8 * HTB, NXCD = 8, WGM = 8;
__host__ __device__ __forceinline__ int lds_byte(int r, int c) { const int st = (r >> 4) * 2 + (c >> 5), rr = r & 15, cc = c & 31, ob = rr * 64 + cc * 2; return st * 1024 + (ob ^ (((ob >> 9) & 1) << 5)); }
__host__ __device__ __forceinline__ void stage_rc(int b, int& R, int& C) { const int st = b / 1024, sb = b % 1024, swz = sb ^ (((sb >> 9) & 1) << 5); R = (st >> 1) * 16 + swz / 64; C = (st & 1) * 32 + (swz % 64) / 2; }
__host__ __device__ __forceinline__ int perm32(int rho) { const int n = rho >> 4, i = rho & 15; return 8 * (i >> 2) + 4 * n + (i & 3); }

struct Unit { int pm, pn, kc; };
struct Gemm { const bf16_t* A; const bf16_t* Bt; int lda, ldb, K, nM, nN, ablk; };

struct StaticOrder {
    int nM, nN, nwg, G, c;
    __device__ void init(int nM_, int nN_, int G_, int c_) { nM = nM_; nN = nN_; nwg = nM * nN; G = G_; c = c_; }
    static constexpr bool SPLIT = false;
    __device__ bool next(int i, Unit& u) const {
        const long L = (long)i * G + c; if (L >= nwg) return false;
        u.kc = -1;
        int wgid = (int)L; { const int q = nwg / NXCD, r = nwg % NXCD, xcd = wgid % NXCD, off = wgid / NXCD; wgid = (xcd < r ? xcd * (q + 1) : r * (q + 1) + (xcd - r) * q) + off; }
        const int nig = WGM * nN, gid = wgid / nig, fm = gid * WGM, gsz = (nM - fm) < WGM ? (nM - fm) : WGM;
        u.pm = fm + ((wgid % nig) % gsz); u.pn = (wgid % nig) / gsz; return true;
    }
};

struct DownOrder {
    int G, c;
    static constexpr bool SPLIT = true;
    __device__ void init(int G_, int c_) { G = G_; c = c_; }
    __device__ bool next(int i, Unit& u) const {
        const int L = i * G + c; if (L >= 256 + 96) return false;
        const bool full = L < 256; const int r = L >> 3, idx = L - 256, tile = idx / 6;
        const int pm = full ? (L & 7) * 8 + (r & 7) : 64 + (tile >> 2), pn = full ? (r >> 3) : (tile & 3), kc = full ? -1 : idx - tile * 6;
        u.pm = pm; u.pn = pn; u.kc = kc;
        return true;
    }
};

template <class Epi, class Sched>
__device__ __forceinline__ void gemm_phase(LAS unsigned char* lds, const Gemm g, const Sched& S, const Epi& E, int wv) {
    const int tid = opaque_tid(wv), wid = __builtin_amdgcn_readfirstlane(tid >> 6), lane = tid & 63, wr = wid >> 2, wc = wid & 3, fr = lane & 15, fq = lane >> 4;
    const int K = opaque_s(g.K), nt = K / BK;
    unsigned voffA[2], voffB[2];
#pragma unroll
    for (int i = 0; i < 2; ++i) { int R, C; stage_rc(tid * 16 + i * 8192, R, C); const int Rb = (R & ~31) + perm32(R & 31);
        voffA[i] = (unsigned)(R * g.lda + C) * 2u; voffB[i] = (unsigned)(Rb * g.ldb + C) * 2u; }
    const size_t kstep = (size_t)(BK * 2);
    const size_t hstepA = (size_t)HALF * g.lda * 2, hstepB = (size_t)HALF * g.ldb * 2;
    const unsigned ldsw = (unsigned)wid * 1024u;
    const int aoff = lds_byte(wr * 64 + fr, fq * 8), boff = lds_byte(wc * 32 + fr, fq * 8);
#define PG8_SA(b, h) (((b) * 2 + (h)) * HTB)
#define PG8_SB(b, h) ((4 + (b) * 2 + (h)) * HTB)
#define PG8_STAGE(bufoff, gbase, voff) do { _Pragma("unroll") for (int _i = 0; _i < 2; ++_i) \
        __builtin_amdgcn_global_load_lds((const unsigned*)((const char*)(gbase) + (voff)[_i]), (LAS unsigned*)(lds + (bufoff) + ldsw + _i * 8192), 16, 0, 0); } while (0)
#define PG8_LDA(dst, b, h) do { _Pragma("unroll") for (int m = 0; m < 4; ++m) _Pragma("unroll") for (int k = 0; k < 2; ++k) dst[m][k] = *(const LAS bf16x8*)(lds + PG8_SA(b, h) + aoff + m * 2048 + k * 1024); } while (0)
#define PG8_LDB(dst, b, h) do { _Pragma("unroll") for (int n = 0; n < 2; ++n) _Pragma("unroll") for (int k = 0; k < 2; ++k) dst[n][k] = *(const LAS bf16x8*)(lds + PG8_SB(b, h) + boff + n * 2048 + k * 1024); } while (0)
#define PG8_MMA(ai, bj, At, Bt) do { __builtin_amdgcn_s_setprio(1); _Pragma("unroll") for (int m = 0; m < 4; ++m) _Pragma("unroll") for (int n = 0; n < 2; ++n) _Pragma("unroll") for (int k = 0; k < 2; ++k) \
        acc[ai][bj][m][n] = __builtin_amdgcn_mfma_f32_16x16x32_bf16(Bt[n][k], At[m][k], acc[ai][bj][m][n], 0, 0, 0); __builtin_amdgcn_s_setprio(0); } while (0)
#define PG8_WAIT_V(n) asm volatile("s_waitcnt vmcnt(" #n ")" ::: "memory")
#define PG8_WAIT_L(n) asm volatile("s_waitcnt lgkmcnt(" #n ")" ::: "memory")
#define PG8_BAR __builtin_amdgcn_s_barrier()
#define PG8_SCHED __builtin_amdgcn_sched_barrier(0)
#define PG8_KOFF(u) ((Sched::SPLIT && (u).kc > 0) ? (size_t)(u).kc * 1024 : (size_t)0)
#define PG8_ABASE(u) ((const char*)g.A + (size_t)(u).pm * 2 * hstepA + (g.ablk ? (size_t)((u).pn >> 1) * 512 : 0) + PG8_KOFF(u))
#define PG8_BBASE(u) ((const char*)g.Bt + (size_t)(u).pn * 2 * hstepB + PG8_KOFF(u))
#define PG8_NT(u) ((Sched::SPLIT && (u).kc >= 0) ? ((u).kc < 5 ? 8 : 4) : nt)
    Unit cur, nxt; int ui = 0;
    if (!S.next(0, cur)) return;
    f32x4 acc[2][2][4][2];
#pragma unroll
    for (int a = 0; a < 2; ++a)
#pragma unroll
        for (int b = 0; b < 2; ++b)
#pragma unroll
            for (int m = 0; m < 4; ++m)
#pragma unroll
                for (int n = 0; n < 2; ++n) acc[a][b][m][n] = (f32x4){0.f, 0.f, 0.f, 0.f};
    bf16x8 At[4][2], B0[2][2], B1[2][2];
    f32x4 pf[4] = {{0.f, 0.f, 0.f, 0.f}, {0.f, 0.f, 0.f, 0.f}, {0.f, 0.f, 0.f, 0.f}, {0.f, 0.f, 0.f, 0.f}};
    const char* cA = PG8_ABASE(cur); const char* cB = PG8_BBASE(cur);
    PG8_STAGE(PG8_SB(0, 0), cB, voffB); PG8_STAGE(PG8_SB(0, 1), cB + hstepB, voffB); PG8_STAGE(PG8_SA(0, 0), cA, voffA); PG8_STAGE(PG8_SA(0, 1), cA + hstepA, voffA);
    if (wr == 1) PG8_BAR;
    PG8_WAIT_V(2); PG8_BAR;
    PG8_STAGE(PG8_SB(1, 0), cB + kstep, voffB); PG8_STAGE(PG8_SA(1, 0), cA + kstep, voffA); PG8_STAGE(PG8_SB(1, 1), cB + hstepB + kstep, voffB);
    PG8_WAIT_V(6); PG8_BAR;
    for (;;) {
        const bool has_next = S.next(ui + 1, nxt);
        const char* nA = has_next ? PG8_ABASE(nxt) : cA; const char* nB = has_next ? PG8_BBASE(nxt) : cB;
        const int ntu = PG8_NT(cur);
#pragma unroll 1
        for (int t = 0; t < ntu; t += 2) {
            const bool last = (t == ntu - 2);
            if (last) E.prefetch(pf, cur, tid);
            const char* a1 = cA + (size_t)(t + 1) * kstep;
            const char* a2 = last ? nA : cA + (size_t)(t + 2) * kstep; const char* b2 = last ? nB : cB + (size_t)(t + 2) * kstep;
            const char* a3 = a2 + kstep; const char* b3 = b2 + kstep;
            PG8_LDB(B0, 0, 0); PG8_LDB(B1, 0, 1); PG8_SCHED; PG8_LDA(At, 0, 0); PG8_STAGE(PG8_SA(1, 1), a1 + hstepA, voffA);
            PG8_WAIT_V(8); PG8_WAIT_L(0); PG8_BAR; PG8_MMA(0, 0, At, B0); PG8_MMA(0, 1, At, B1); PG8_BAR; PG8_SCHED;
            PG8_LDA(At, 0, 1); PG8_STAGE(PG8_SB(0, 0), b2, voffB); PG8_STAGE(PG8_SB(0, 1), b2 + hstepB, voffB); PG8_STAGE(PG8_SA(0, 0), a2, voffA);
            PG8_WAIT_V(8); PG8_WAIT_L(0); PG8_BAR; PG8_MMA(1, 0, At, B0); PG8_MMA(1, 1, At, B1); PG8_BAR; PG8_SCHED;
            PG8_LDB(B0, 1, 0); PG8_LDB(B1, 1, 1); PG8_SCHED; PG8_LDA(At, 1, 0); PG8_STAGE(PG8_SA(0, 1), a2 + hstepA, voffA);
            PG8_WAIT_V(8); PG8_WAIT_L(0); PG8_BAR; PG8_MMA(0, 0, At, B0); PG8_MMA(0, 1, At, B1); PG8_BAR; PG8_SCHED;
            PG8_LDA(At, 1, 1); PG8_STAGE(PG8_SB(1, 0), b3, voffB); PG8_STAGE(PG8_SB(1, 1), b3 + hstepB, voffB); PG8_STAGE(PG8_SA(1, 0), a3, voffA);
            PG8_WAIT_V(8); PG8_WAIT_L(0); PG8_BAR; PG8_MMA(1, 0, At, B0); PG8_MMA(1, 1, At, B1); PG8_BAR; PG8_SCHED;
        }
        if (wr == 0) PG8_BAR;
        E(acc, cur, wr, wc, fr, fq, pf);
        if (!has_next) break;
#pragma unroll
        for (int a = 0; a < 2; ++a)
#pragma unroll
            for (int b = 0; b < 2; ++b)
#pragma unroll
                for (int m = 0; m < 4; ++m)
#pragma unroll
                    for (int n = 0; n < 2; ++n) acc[a][b][m][n] = (f32x4){0.f, 0.f, 0.f, 0.f};
        cur = nxt; cA = nA; cB = nB; ++ui;
        if (wr == 1) PG8_BAR;
    }
    PG8_WAIT_V(0);
    PG8_BAR;
#undef PG8_SA
#undef PG8_SB
#undef PG8_STAGE
#undef PG8_LDA
#undef PG8_LDB
#undef PG8_MMA
#undef PG8_WAIT_V
#undef PG8_WAIT_L
#undef PG8_BAR
#undef PG8_SCHED
#undef PG8_ABASE
#undef PG8_BBASE
#undef PG8_KOFF
#undef PG8_NT
}
}
using pg8::Unit; using pg8::HALF;

struct EpiSwiGLU {
    bf16_t* ACT; const float* ss; LAS float* rsl;
    __device__ __forceinline__ void prefetch(f32x4 (&pf)[4], const Unit& u, int tid) const { rstd_prefetch(pf, ss, u.pm, tid); }
    __device__ __forceinline__ void operator()(const f32x4 (&acc)[2][2][4][2], const Unit& u, int wr, int wc, int fr, int fq, const f32x4 (&pf)[4]) const {
        const int row0 = u.pm * 256 + wr * 64 + fr, col0 = u.pn * 128 + wc * 32 + 8 * fq;
        unit_rstd(pf, rsl, (wr * 4 + wc) * 64 + fq * 16 + fr);
        float rsv[2][4];
#pragma unroll
        for (int ai = 0; ai < 2; ++ai)
#pragma unroll
            for (int m = 0; m < 4; ++m) rsv[ai][m] = rsl[ai * HALF + wr * 64 + m * 16 + fr];
#pragma unroll
        for (int ai = 0; ai < 2; ++ai)
#pragma unroll
            for (int m = 0; m < 4; ++m) {
                const int row = row0 + ai * HALF + m * 16; const float rs = rsv[ai][m], nl = -1.4426950409f * rs, rs2 = rs * rs;
                float h[8];
#pragma unroll
                for (int n = 0; n < 2; ++n)
#pragma unroll
                    for (int j = 0; j < 4; ++j) { const float g = acc[ai][0][m][n][j], uu = acc[ai][1][m][n][j];
                        h[n * 4 + j] = (g * uu) * (rs2 * fast_rcp(1.f + __builtin_amdgcn_exp2f(g * nl))); }
                u32x4 w; w.x = cvt_pk_bf16(h[0], h[1]); w.y = cvt_pk_bf16(h[2], h[3]); w.z = cvt_pk_bf16(h[4], h[5]); w.w = cvt_pk_bf16(h[6], h[7]);
                st16_wt(ACT + (size_t)row * DFF + col0, w);
            }
    }
};
struct EpiResid {
    float* X; bf16_t* XB; float* ssn; float scale; float* PART;
    __device__ __forceinline__ void prefetch(f32x4 (&)[4], const Unit&, int) const {}
    __device__ __forceinline__ void operator()(const f32x4 (&acc)[2][2][4][2], const Unit& u, int wr, int wc, int fr, int fq, const f32x4 (&pf)[4]) const {
        const int row0 = u.pm * 256 + wr * 64 + fr, col0 = u.pn * 256 + wc * 32 + 8 * fq;
        if (u.kc >= 0) {
#pragma unroll
            for (int ai = 0; ai < 2; ++ai)
#pragma unroll
                for (int m = 0; m < 4; ++m) {
                    const int row = row0 + ai * HALF + m * 16 - MP;
#pragma unroll
                    for (int bj = 0; bj < 2; ++bj) { float* pp = PART + ((size_t)u.kc * MS + row) * D + col0 + bj * HALF; *(GAS f32x4*)pp = acc[ai][bj][m][0]; *(GAS f32x4*)(pp + 4) = acc[ai][bj][m][1]; }
                }
            return;
        }
        u32x4 oldx[2][4][2];
#pragma unroll
        for (int ai = 0; ai < 2; ++ai)
#pragma unroll
            for (int m = 0; m < 4; ++m)
#pragma unroll
                for (int bj = 0; bj < 2; ++bj) oldx[ai][m][bj] = *(const GAS u32x4*)(XB + (size_t)(row0 + ai * HALF + m * 16) * D + col0 + bj * HALF);
#pragma unroll
        for (int ai = 0; ai < 2; ++ai)
#pragma unroll
            for (int m = 0; m < 4; ++m) {
                const int row = row0 + ai * HALF + m * 16; float s = 0.f;
#pragma unroll
                for (int bj = 0; bj < 2; ++bj) {
                    bf16_t* xp = XB + (size_t)row * D + col0 + bj * HALF;
                    const u32x4 o = oldx[ai][m][bj];
                    f32x4 a = (f32x4){bf_lo(o.x), bf_hi(o.x), bf_lo(o.y), bf_hi(o.y)}, b = (f32x4){bf_lo(o.z), bf_hi(o.z), bf_lo(o.w), bf_hi(o.w)};
                    a = a + acc[ai][bj][m][0] * scale; b = b + acc[ai][bj][m][1] * scale;
                    u32x4 w; w.x = cvt_pk_bf16(a.x, a.y); w.y = cvt_pk_bf16(a.z, a.w); w.z = cvt_pk_bf16(b.x, b.y); w.w = cvt_pk_bf16(b.z, b.w);
                    st16_wt(xp, w);
                    a = (f32x4){bf_lo(w.x), bf_hi(w.x), bf_lo(w.y), bf_hi(w.y)}; b = (f32x4){bf_lo(w.z), bf_hi(w.z), bf_lo(w.w), bf_hi(w.w)};
                    s += (a.x * a.x + a.y * a.y) + (a.z * a.z + a.w * a.w) + (b.x * b.x + b.y * b.y) + (b.z * b.z + b.w * b.w);
                }
                s += __shfl_xor(s, 16); s += __shfl_xor(s, 32);
                if (fq == 0) *(GAS float*)(ssn + (size_t)row * 16 + u.pn * 4 + wc) = s;
            }
    }
};
struct EpiRgIn {
    bf16_t* GG; bf16_t* XR; const float* ss; LAS float* rsl;
    __device__ __forceinline__ void prefetch(f32x4 (&pf)[4], const Unit& u, int tid) const { rstd_prefetch(pf, ss, u.pm, tid); }
    __device__ __forceinline__ void operator()(const f32x4 (&acc)[2][2][4][2], const Unit& u, int wr, int wc, int fr, int fq, const f32x4 (&pf)[4]) const {
        const int row0 = u.pm * 256 + wr * 64 + fr, col0 = (u.pn & 3) * 256 + wc * 32 + 8 * fq;
        const bool is_gate = u.pn < 4;
        unit_rstd(pf, rsl, (wr * 4 + wc) * 64 + fq * 16 + fr);
#pragma unroll
        for (int ai = 0; ai < 2; ++ai)
#pragma unroll
            for (int m = 0; m < 4; ++m) {
                const int row = row0 + ai * HALF + m * 16; const float rs = rsl[ai * HALF + wr * 64 + m * 16 + fr];
#pragma unroll
                for (int bj = 0; bj < 2; ++bj) {
                    const f32x4 a = acc[ai][bj][m][0] * rs, b = acc[ai][bj][m][1] * rs;
                    const size_t off = (size_t)row * D + col0 + bj * HALF;
                    if (is_gate) {
                        u32x4 w; w.x = cvt_pk_bf16(gelu_tanh_(a.x), gelu_tanh_(a.y)); w.y = cvt_pk_bf16(gelu_tanh_(a.z), gelu_tanh_(a.w));
                        w.z = cvt_pk_bf16(gelu_tanh_(b.x), gelu_tanh_(b.y)); w.w = cvt_pk_bf16(gelu_tanh_(b.z), gelu_tanh_(b.w));
                        *(GAS u32x4*)(GG + off) = w;
                    } else { u32x4 w; w.x = cvt_pk_bf16(a.x, a.y); w.y = cvt_pk_bf16(a.z, a.w); w.z = cvt_pk_bf16(b.x, b.y); w.w = cvt_pk_bf16(b.z, b.w); *(GAS u32x4*)(XR + off) = w; }
                }
            }
    }
};
struct EpiGates {
    unsigned char* MIXp; const float* tab;
    __device__ __forceinline__ void prefetch(f32x4 (&)[4], const Unit&, int) const {}
    __device__ __forceinline__ void operator()(const f32x4 (&acc)[2][2][4][2], const Unit& u, int wr, int wc, int fr, int fq, const f32x4 (&pf)[4]) const {
        const int row0 = u.pm * 256 + wr * 64 + fr, ch0 = (u.pn >> 1) * 256 + (u.pn & 1) * 128 + wc * 32 + 8 * fq;
        u32x4 xcw[2][4]; f32x4 ba[2], bx[2], sp[2];
#pragma unroll
        for (int ai = 0; ai < 2; ++ai)
#pragma unroll
            for (int m = 0; m < 4; ++m) xcw[ai][m] = *(const GAS u32x4*)((const bf16_t*)(MIXp + MIX_XC) + (size_t)(row0 + ai * HALF + m * 16) * D + ch0);
#pragma unroll
        for (int n = 0; n < 2; ++n) { ba[n] = *(const GAS f32x4*)(tab + ch0 + 4 * n); bx[n] = *(const GAS f32x4*)(tab + D + ch0 + 4 * n); sp[n] = *(const GAS f32x4*)(tab + 2 * D + ch0 + 4 * n); }
#pragma unroll
        for (int ai = 0; ai < 2; ++ai)
#pragma unroll
            for (int m = 0; m < 4; ++m) {
                const int row = row0 + ai * HALF + m * 16; const size_t off = (size_t)row * D + ch0;
                const u32x4 xw = xcw[ai][m];
                const float xc[8] = {bf_lo(xw.x), bf_hi(xw.x), bf_lo(xw.y), bf_hi(xw.y), bf_lo(xw.z), bf_hi(xw.z), bf_lo(xw.w), bf_hi(xw.w)};
                h16x8 la8, u8;
#pragma unroll
                for (int n = 0; n < 2; ++n) {
#pragma unroll
                    for (int jx = 0; jx < 4; ++jx) {
                        const float r = sigmoidf_(acc[ai][0][m][n][jx] + ba[n][jx]), ig = sigmoidf_(acc[ai][1][m][n][jx] + bx[n][jx]);
                        const float la = r * sp[n][jx], x2 = 2.f * la;
                        const float om = (x2 > -0.03f) ? -x2 * (1.f + x2 * (0.5f + x2 * (0.16666667f + x2 * 0.041666668f))) : 1.f - __expf(x2);
                        const float uu = __builtin_amdgcn_sqrtf(fmaxf(om, 0.f)) * (ig * xc[n * 4 + jx]);
                        la8[n * 4 + jx] = (_Float16)la; u8[n * 4 + jx] = (_Float16)uu;
                    }
                }
                { union { h16x8 h; u32x4 u; } c0, c1; c0.h = la8; c1.h = u8; st16_wt((_Float16*)(MIXp + MIX_XR) + off, c0.u); st16_wt((_Float16*)(MIXp + MIX_U) + off, c1.u); }
            }
    }
};
struct EpiQ {
    bf16_t* Q; const float* ss; LAS float* rsl;
    __device__ __forceinline__ void prefetch(f32x4 (&pf)[4], const Unit& u, int tid) const { rstd_prefetch(pf, ss, u.pm, tid); }
    __device__ __forceinline__ void operator()(const f32x4 (&acc)[2][2][4][2], const Unit& u, int wr, int wc, int fr, int fq, const f32x4 (&pf)[4]) const {
        const int row0 = u.pm * 256 + wr * 64 + fr, col0 = u.pn * 256 + wc * 32 + 8 * fq;
        unit_rstd(pf, rsl, (wr * 4 + wc) * 64 + fq * 16 + fr);
        float rsv[2][4];
#pragma unroll
        for (int ai = 0; ai < 2; ++ai)
#pragma unroll
            for (int m = 0; m < 4; ++m) rsv[ai][m] = rsl[ai * HALF + wr * 64 + m * 16 + fr];
#pragma unroll
        for (int ai = 0; ai < 2; ++ai)
#pragma unroll
            for (int m = 0; m < 4; ++m) {
                const int row = row0 + ai * HALF + m * 16; const float rs = rsv[ai][m];
#pragma unroll
                for (int bj = 0; bj < 2; ++bj) {
                    const f32x4 a = acc[ai][bj][m][0] * rs, b = acc[ai][bj][m][1] * rs;
                    u32x4 w; w.x = cvt_pk_bf16(a.x, a.y); w.y = cvt_pk_bf16(a.z, a.w); w.z = cvt_pk_bf16(b.x, b.y); w.w = cvt_pk_bf16(b.z, b.w);
                    st16_wt(Q + (size_t)row * D + col0 + bj * HALF, w);
                }
            }
    }
};
struct EpiKV {
    bf16_t* KVB; float* out; const float* ss; LAS float* rsl;
    __device__ __forceinline__ void prefetch(f32x4 (&pf)[4], const Unit& u, int tid) const { rstd_prefetch(pf, ss, u.pm, tid); }
    __device__ __forceinline__ void operator()(const f32x4 (&acc)[2][2][4][2], const Unit& u, int wr, int wc, int fr, int fq, const f32x4 (&pf)[4]) const {
        const int row0 = u.pm * 256 + wr * 64 + fr, col0 = wc * 32 + 8 * fq;
        unit_rstd(pf, rsl, (wr * 4 + wc) * 64 + fq * 16 + fr);
#pragma unroll
        for (int ai = 0; ai < 2; ++ai)
#pragma unroll
            for (int m = 0; m < 4; ++m) {
                const int row = row0 + ai * HALF + m * 16; const float rs = rsl[ai * HALF + wr * 64 + m * 16 + fr];
                long obase = -1;
                size_t okoff = O_PK, ovoff = O_PV;
                if (row < MP) { const int b = row >> 12, t = row & 4095; if (t >= SEQ - 128) obase = ((long)b * 128 + (t - (SEQ - 128))) * 128; }
                else { const int s = (row - MP) >> 3, i = (row - MP) & 7; obase = ((long)s * 128 + 120 + i) * 128; okoff = O_SK; ovoff = O_SV; }
#pragma unroll
                for (int bj = 0; bj < 2; ++bj) {
                    const f32x4 a = acc[ai][bj][m][0] * rs, b = acc[ai][bj][m][1] * rs;
                    u32x4 w; w.x = cvt_pk_bf16(a.x, a.y); w.y = cvt_pk_bf16(a.z, a.w); w.z = cvt_pk_bf16(b.x, b.y); w.w = cvt_pk_bf16(b.z, b.w);
                    *(GAS u32x4*)(KVB + (size_t)row * 256 + bj * HALF + col0) = w;
                    if (obase >= 0) { float* o = out + (bj ? ovoff : okoff) + obase + col0; *(GAS f32x4*)o = a; *(GAS f32x4*)(o + 4) = b; }
                }
            }
    }
};

__device__ __forceinline__ void prep_macro(const float* s0, const float* s1, const float* s2, const float* s3, int ldsrc, int k0, const float* gain, float cs, bf16_t* dst, int ldd, int n0, LAS float* scr, int tid) {
    const float* srcq[4] = {s0, s1, s2, s3};
    f32x4 v[4][2];
#pragma unroll
    for (int q = 0; q < 4; ++q)
#pragma unroll
        for (int i = 0; i < 2; ++i) { const int kk = (tid >> 4) + 32 * i, cc = (tid & 15) * 4; v[q][i] = *(const f32x4*)(srcq[q] + (size_t)(k0 + kk) * ldsrc + cc); }
    float g[2];
#pragma unroll
    for (int i = 0; i < 2; ++i) g[i] = gain ? cs * gain[k0 + (tid >> 4) + 32 * i] : cs;
#pragma unroll
    for (int q = 0; q < 4; ++q)
#pragma unroll
        for (int i = 0; i < 2; ++i) { const int kk = (tid >> 4) + 32 * i, cc = (tid & 15) * 4; LAS float* s = scr + q * 4160 + kk * 65 + cc;
            s[0] = v[q][i].x * g[i]; s[1] = v[q][i].y * g[i]; s[2] = v[q][i].z * g[i]; s[3] = v[q][i].w * g[i]; }
    __syncthreads();
    const int n = tid >> 3, c = tid & 7;
#pragma unroll
    for (int q = 0; q < 4; ++q) { const LAS float* s = scr + q * 4160 + (8 * c) * 65 + n;
        u32x4 o; o.x = cvt_pk_bf16(s[0], s[65]); o.y = cvt_pk_bf16(s[130], s[195]); o.z = cvt_pk_bf16(s[260], s[325]); o.w = cvt_pk_bf16(s[390], s[455]);
        *(u32x4*)(dst + (size_t)(n0 + 64 * q + n) * ldd + k0 + 8 * c) = o; }
    __syncthreads();
}
__device__ __forceinline__ void prep_plain(const float* src, int ldsrc, int kt, int nt4, const float* gain, float cs, bf16_t* dst, int ldd, LAS float* scr, int tid) {
    const float* b = src + 256 * nt4; prep_macro(b, b + 64, b + 128, b + 192, ldsrc, kt * 64, gain, cs, dst, ldd, 256 * nt4, scr, tid);
}

__device__ __forceinline__ void phase_prep(const Params& P, LAS unsigned char* lds, int wv) {
    const int tid = opaque_tid(wv), lane = tid & 63, wave = tid >> 6, G = opaque_s((int)gridDim.x), bid = opaque_s((int)blockIdx.x);
    LAS float* scr = (LAS float*)lds;
    bf16_t* W = (bf16_t*)(P.ws + WS_W);
    constexpr int I_GU = 8 * 352, I_D = I_GU + 8 * 176, I_IN = I_D + 2 * 128, I_OUT = I_IN + 2 * 64, I_KV = I_OUT + 16, I_Q = I_KV + 2 * 64, I_O = I_Q + 2 * 64, I_G = I_O + 2 * 32;
    for (int it = bid; it < I_G; it += G) {
        if (it < I_GU) { const int j = it / 352, r = it % 352, l = j >> 1, f = j & 1, kt = r & 15, pn = r >> 4;
            const float* b = P.in[f ? 11 : 7] + (size_t)l * D * NGU + 128 * pn;
            prep_macro(b, b + 64, b + DFF, b + DFF + 64, NGU, kt * 64, P.in[f ? 10 : 6] + l * D, 1.f, W + W_GU + (size_t)j * NGU * D, D, 256 * pn, scr, tid);
        } else if (it < I_D) { const int q = it - I_GU, j = q / 176, r = q % 176, l = j >> 1, f = j & 1, kt = r % 44, nt4 = r / 44;
            prep_plain(P.in[f ? 12 : 8] + (size_t)l * DFF * D, D, kt, nt4, nullptr, 1.f, W + W_D + (size_t)j * D * DFF, DFF, scr, tid);
        } else if (it < I_IN) { const int q = it - I_D, l = q / 128, r = q % 128, kt = r & 15, nt4 = r >> 4;
            prep_plain(P.in[13] + (size_t)l * D * 2048, 2048, kt, nt4, P.in[9] + l * D, 1.f, W + W_IN + (size_t)l * 2048 * D, D, scr, tid);
        } else if (it < I_OUT) { const int q = it - I_IN, l = q / 64, r = q % 64, kt = r & 15, nt4 = r >> 4;
            prep_plain(P.in[21] + (size_t)l * D * D, D, kt, nt4, nullptr, 1.f, W + W_OUT + (size_t)l * D * D, D, scr, tid);
        } else if (it < I_KV) { const int r = it - I_OUT, kt = r & 15;
            prep_plain(P.in[23], 256, kt, 0, P.in[22], 1.f, W + W_KV, D, scr, tid);
        } else if (it < I_Q) { const int q = it - I_KV, l = q / 64, r = q % 64, kt = r & 15, nt4 = r >> 4;
            prep_plain(P.in[24] + (size_t)l * D * D, D, kt, nt4, P.in[9] + (2 + l) * D, 0.125f, W + W_Q + (size_t)l * D * D, D, scr, tid);
        } else if (it < I_O) { const int q = it - I_Q, l = q / 64, r = q % 64, kt = r & 15, nt4 = r >> 4;
            prep_plain(P.in[26] + (size_t)l * D * D, D, kt, nt4, nullptr, 1.f, W + W_O + (size_t)l * D * D, D, scr, tid);
        } else { const int q = it - I_O, l = q / 32, r = q % 32, kt = r & 3, pn = r >> 2, nb = pn >> 1, hh = pn & 1;
            const float* a = P.in[16] + (size_t)l * 4 * 65536 + (size_t)nb * 65536 + hh * 128; const float* x = P.in[18] + (size_t)l * 4 * 65536 + (size_t)nb * 65536 + hh * 128;
            prep_macro(a, a + 64, x, x + 64, 256, kt * 64, nullptr, 1.f, W + W_G + (size_t)l * 2048 * 256, 256, 256 * pn, scr, tid);
        }
    }
    float* X = P.out + O_X; bf16_t* XB = (bf16_t*)(P.ws + WS_XB); float* SS = (float*)(P.ws + WS_SSP);
    const int gw = bid * 8 + wave, NGW = G * 8;
    for (int row = gw; row < M; row += 2 * NGW) {
        const int row2 = row + NGW; const bool has2 = row2 < M; const int r2 = has2 ? row2 : row;
        const float* src = row < MP ? P.in[0] + (size_t)row * D : P.in[1] + (size_t)(row - MP) * D;
        const float* src2 = r2 < MP ? P.in[0] + (size_t)r2 * D : P.in[1] + (size_t)(r2 - MP) * D;
        f32x4 v[4], v2[4];
#pragma unroll
        for (int j = 0; j < 4; ++j) { v[j] = *(const f32x4*)(src + j * 256 + lane * 4); v2[j] = *(const f32x4*)(src2 + j * 256 + lane * 4); }
        float s = 0.f, s2 = 0.f;
#pragma unroll
        for (int j = 0; j < 4; ++j) {
            u32x2 w; w.x = cvt_pk_bf16(v[j].x, v[j].y); w.y = cvt_pk_bf16(v[j].z, v[j].w);
            *(u32x2*)(XB + (size_t)row * D + j * 256 + lane * 4) = w;
            const f32x4 q = (f32x4){bf_lo(w.x), bf_hi(w.x), bf_lo(w.y), bf_hi(w.y)};
            s += (q.x * q.x + q.y * q.y) + (q.z * q.z + q.w * q.w);
            u32x2 w2; w2.x = cvt_pk_bf16(v2[j].x, v2[j].y); w2.y = cvt_pk_bf16(v2[j].z, v2[j].w);
            if (has2) *(u32x2*)(XB + (size_t)row2 * D + j * 256 + lane * 4) = w2;
            const f32x4 q2 = (f32x4){bf_lo(w2.x), bf_hi(w2.x), bf_lo(w2.y), bf_hi(w2.y)};
            s2 += (q2.x * q2.x + q2.y * q2.y) + (q2.z * q2.z + q2.w * q2.w);
        }
#pragma unroll
        for (int o = 1; o < 64; o <<= 1) { s += __shfl_xor(s, o); s2 += __shfl_xor(s2, o); }
        if (lane < 16) { SS[(size_t)row * 16 + lane] = lane == 0 ? s : 0.f; if (has2) SS[(size_t)row2 * 16 + lane] = lane == 0 ? s2 : 0.f; }
    }
    const int gt = bid * NTHR + tid, NGT = G * NTHR;
    if (gt < 2 * D) { const int l = gt >> 10, c = gt & 1023; const float z = -P.in[20][gt]; float* tab = (float*)(P.ws + WS_SPT) + l * 3 * D;
        tab[c] = P.in[17][gt]; tab[D + c] = P.in[19][gt]; tab[2 * D + c] = -8.0f * (fmaxf(z, 0.f) + log1pf(expf(-fabsf(z)))); }
    bf16_t* CKB = (bf16_t*)(P.ws + WS_CKB);
    for (int i = gt; i < 2 * DB * 4096; i += NGT) {
        const int which = i / (DB * 4096), r = i % (DB * 4096), s = r / 4096, q = r % 4096;
        const f32x4 v = *(const f32x4*)(P.in[4 + which] + (size_t)s * 16384 + q * 4);
        if (q >= 256) *(f32x4*)(P.out + (which ? O_SV : O_SK) + (size_t)s * 16384 + (q - 256) * 4) = v;
        u32x2 w; w.x = cvt_pk_bf16(v.x, v.y); w.y = cvt_pk_bf16(v.z, v.w);
        *(u32x2*)(CKB + (size_t)which * DB * 16384 + (size_t)s * 16384 + q * 4) = w;
    }
}

__device__ __forceinline__ void phase_conv(const Params& P, int l, int wv) {
    const int tid = opaque_tid(wv), rc = tid >> 7, c8 = (tid & 127) * 8;
    const bf16_t* XR = (const bf16_t*)(P.ws + WS_MIX + MIX_XR); bf16_t* XC = (bf16_t*)(P.ws + WS_MIX + MIX_XC);
    const float* cw = P.in[14] + (size_t)l * 4 * D; const float* cb = P.in[15] + (size_t)l * D;
    float w[4][8], bb[8];
#pragma unroll
    for (int k = 0; k < 4; ++k) { const f32x4 a = *(const f32x4*)(cw + k * D + c8), b = *(const f32x4*)(cw + k * D + c8 + 4);
        w[k][0] = a.x; w[k][1] = a.y; w[k][2] = a.z; w[k][3] = a.w; w[k][4] = b.x; w[k][5] = b.y; w[k][6] = b.z; w[k][7] = b.w; }
    { const f32x4 a = *(const f32x4*)(cb + c8), b = *(const f32x4*)(cb + c8 + 4); bb[0] = a.x; bb[1] = a.y; bb[2] = a.z; bb[3] = a.w; bb[4] = b.x; bb[5] = b.y; bb[6] = b.z; bb[7] = b.w; }
    for (int u = opaque_s((int)blockIdx.x); u < M / 32; u += opaque_s((int)gridDim.x)) {
        const int r0 = u * 32 + rc * 8;
        const bool samp = r0 >= MP; const int t0 = samp ? 0 : (r0 & 4095); const int sq = samp ? (r0 - MP) >> 3 : (r0 >> 12);
        float h[3][8];
#pragma unroll
        for (int k = 0; k < 3; ++k) {
            if (t0 > 0) { const u32x4 w = *(const u32x4*)(XR + (size_t)(r0 - 3 + k) * D + c8);
                h[k][0] = bf_lo(w.x); h[k][1] = bf_hi(w.x); h[k][2] = bf_lo(w.y); h[k][3] = bf_hi(w.y); h[k][4] = bf_lo(w.z); h[k][5] = bf_hi(w.z); h[k][6] = bf_lo(w.w); h[k][7] = bf_hi(w.w); }
            else if (samp) { const float* src = P.in[3] + (((size_t)l * DB + sq) * 3 + k) * D + c8;
                const f32x4 a = *(const f32x4*)src, b = *(const f32x4*)(src + 4); h[k][0] = a.x; h[k][1] = a.y; h[k][2] = a.z; h[k][3] = a.w; h[k][4] = b.x; h[k][5] = b.y; h[k][6] = b.z; h[k][7] = b.w; }
            else {
#pragma unroll
                for (int e = 0; e < 8; ++e) h[k][e] = 0.f; }
        }
        const bool tail = samp || (t0 == SEQ - 8);
        float* so = P.out + (samp ? O_SC + (((size_t)l * DB + sq) * 3) * D : O_PC + (((size_t)l * NSEQ + sq) * 3) * D) + c8;
        u32x4 xrow[8];
#pragma unroll
        for (int i = 0; i < 8; ++i) xrow[i] = *(const u32x4*)(XR + (size_t)(r0 + i) * D + c8);
#pragma unroll
        for (int i = 0; i < 8; ++i) {
            const u32x4 xw = xrow[i];
            const float cur[8] = {bf_lo(xw.x), bf_hi(xw.x), bf_lo(xw.y), bf_hi(xw.y), bf_lo(xw.z), bf_hi(xw.z), bf_lo(xw.w), bf_hi(xw.w)};
            const f32x4 a = (f32x4){cur[0], cur[1], cur[2], cur[3]}, b = (f32x4){cur[4], cur[5], cur[6], cur[7]};
            float y[8];
#pragma unroll
            for (int e = 0; e < 8; ++e) { y[e] = bb[e] + w[0][e] * h[0][e] + w[1][e] * h[1][e] + w[2][e] * h[2][e] + w[3][e] * cur[e]; h[0][e] = h[1][e]; h[1][e] = h[2][e]; h[2][e] = cur[e]; }
            u32x4 o; o.x = cvt_pk_bf16(y[0], y[1]); o.y = cvt_pk_bf16(y[2], y[3]); o.z = cvt_pk_bf16(y[4], y[5]); o.w = cvt_pk_bf16(y[6], y[7]);
            *(u32x4*)(XC + (size_t)(r0 + i) * D + c8) = o;
            if (tail && i >= 5) { *(f32x4*)(so + (size_t)(i - 5) * D) = a; *(f32x4*)(so + (size_t)(i - 5) * D + 4) = b; }
        }
    }
}

__device__ __forceinline__ void phase_scan1(const Params& P, int wv) {
    const int tid = opaque_tid(wv), ch = tid * 2;
    const _Float16* LA = (const _Float16*)(P.ws + WS_MIX + MIX_XR); const _Float16* U = (const _Float16*)(P.ws + WS_MIX + MIX_U);
    float* CS = (float*)(P.ws + WS_CARRY); float* CH = CS + 256 * 1024;
    for (int u = opaque_s((int)blockIdx.x); u < 256; u += opaque_s((int)gridDim.x)) {
        const size_t base = (size_t)u * 64 * D + ch;
        float s0 = 0.f, s1 = 0.f, h0 = 0.f, h1 = 0.f;
#pragma unroll 8
        for (int t = 0; t < 64; ++t) {
            const h16x2 la = *(const h16x2*)(LA + base + (size_t)t * D), uu = *(const h16x2*)(U + base + (size_t)t * D);
            const float l0 = (float)la.x, l1 = (float)la.y;
            h0 = __expf(l0) * h0 + (float)uu.x; h1 = __expf(l1) * h1 + (float)uu.y; s0 += l0; s1 += l1;
        }
        *(f32x2*)(CS + (size_t)u * D + ch) = (f32x2){s0, s1}; *(f32x2*)(CH + (size_t)u * D + ch) = (f32x2){h0, h1};
    }
}
__device__ __forceinline__ void phase_scan3(const Params& P, int l, int wv) {
    const int tid = opaque_tid(wv), ch = tid * 2;
    const _Float16* LA = (const _Float16*)(P.ws + WS_MIX + MIX_XR); const _Float16* U = (const _Float16*)(P.ws + WS_MIX + MIX_U);
    const bf16_t* GG = (const bf16_t*)(P.ws + WS_MIX + MIX_GG); bf16_t* HG = (bf16_t*)(P.ws + WS_MIX + MIX_XC);
    const float* CS = (const float*)(P.ws + WS_CARRY); const float* CH = CS + 256 * 1024;
    for (int u = opaque_s((int)blockIdx.x); u < 256 + 16; u += opaque_s((int)gridDim.x)) {
        if (u < 256) {
            const int b = u >> 6, c = u & 63;
            float h0 = 0.f, h1 = 0.f;
#pragma unroll 8
            for (int cc = 0; cc < c; ++cc) {
                const f32x2 s = *(const f32x2*)(CS + (size_t)(b * 64 + cc) * D + ch), hh = *(const f32x2*)(CH + (size_t)(b * 64 + cc) * D + ch);
                h0 = __expf(s.x) * h0 + hh.x; h1 = __expf(s.y) * h1 + hh.y;
            }
            const size_t base = (size_t)u * 64 * D + ch;
#pragma unroll 1
            for (int tb = 0; tb < 64; tb += 8) {
                h16x2 la[8], uu[8]; unsigned g[8], hg[8];
#pragma unroll
                for (int t = 0; t < 8; ++t) { const size_t o = base + (size_t)(tb + t) * D; la[t] = *(const h16x2*)(LA + o); uu[t] = *(const h16x2*)(U + o); g[t] = *(const unsigned*)(GG + o); }
#pragma unroll
                for (int t = 0; t < 8; ++t) { h0 = __expf((float)la[t].x) * h0 + (float)uu[t].x; h1 = __expf((float)la[t].y) * h1 + (float)uu[t].y; hg[t] = cvt_pk_bf16(h0 * bf_lo(g[t]), h1 * bf_hi(g[t])); }
#pragma unroll
                for (int t = 0; t < 8; ++t) *(unsigned*)(HG + base + (size_t)(tb + t) * D) = hg[t];
            }
            if (c == 63) *(f32x2*)(P.out + O_PH + ((size_t)l * NSEQ + b) * D + ch) = (f32x2){h0, h1};
        } else {
            const int v = u - 256;
            for (int q = 0; q < 8; ++q) {
                const int s = v * 8 + q;
                const f32x2 hi = *(const f32x2*)(P.in[2] + ((size_t)l * DB + s) * D + ch);
                float h0 = hi.x, h1 = hi.y;
                const size_t base = (size_t)(MP + s * 8) * D + ch;
                h16x2 la[8], uu[8]; unsigned g[8], hg[8];
#pragma unroll
                for (int t = 0; t < 8; ++t) { const size_t o = base + (size_t)t * D; la[t] = *(const h16x2*)(LA + o); uu[t] = *(const h16x2*)(U + o); g[t] = *(const unsigned*)(GG + o); }
#pragma unroll
                for (int t = 0; t < 8; ++t) { h0 = __expf((float)la[t].x) * h0 + (float)uu[t].x; h1 = __expf((float)la[t].y) * h1 + (float)uu[t].y; hg[t] = cvt_pk_bf16(h0 * bf_lo(g[t]), h1 * bf_hi(g[t])); }
#pragma unroll
                for (int t = 0; t < 8; ++t) *(unsigned*)(HG + base + (size_t)t * D) = hg[t];
                *(f32x2*)(P.out + O_SH + ((size_t)l * DB + s) * D + ch) = (f32x2){h0, h1};
            }
        }
    }
}

constexpr int KROW = 144;
constexpr int VROW = 560;
constexpr int KS_BYTES = 272 * KROW, VT_OFF = KS_BYTES;
__device__ __forceinline__ void attn_tile(LAS const unsigned char* Ks, LAS const unsigned char* Vt, int kt0, const bf16_t* qptr, bf16_t* optr,
                                          float slope, float sink, int diff0, int dmax, int lane) {
    const int j = lane & 15, g = lane >> 4;
    bf16x8 qf[2];
    qf[0] = *(const bf16x8*)(qptr + g * 8); qf[1] = *(const bf16x8*)(qptr + 32 + g * 8);
    f32x4 s[10];
#pragma unroll
    for (int kt = 0; kt < 10; ++kt) {
        f32x4 a = (f32x4){0.f, 0.f, 0.f, 0.f};
#pragma unroll
        for (int ks = 0; ks < 2; ++ks) {
            const bf16x8 kf = *(LAS const bf16x8*)(Ks + ((kt0 + kt) * 16 + j) * KROW + (ks * 32 + g * 8) * 2);
            a = __builtin_amdgcn_mfma_f32_16x16x32_bf16(kf, qf[ks], a, 0, 0, 0);
        }
        s[kt] = a;
        if (kt & 1) __builtin_amdgcn_sched_barrier(0);
    }
    float mx = sink;
#pragma unroll
    for (int kt = 0; kt < 10; ++kt)
#pragma unroll
        for (int r = 0; r < 4; ++r) {
            const int diff = diff0 - kt * 16 - r; const bool ok = (diff >= 0) && (diff <= dmax);
            const float v = ok ? s[kt][r] - slope * (float)diff : -1e30f; s[kt][r] = v; mx = fmaxf(mx, v);
        }
    mx = fmaxf(mx, __shfl_xor(mx, 16)); mx = fmaxf(mx, __shfl_xor(mx, 32));
    float sum = 0.f;
#pragma unroll
    for (int kt = 0; kt < 10; ++kt)
#pragma unroll
        for (int r = 0; r < 4; ++r) { const float p = __expf(s[kt][r] - mx); s[kt][r] = p; sum += p; }
    sum += __shfl_xor(sum, 16); sum += __shfl_xor(sum, 32);
    sum += __expf(sink - mx);
    const float inv = 1.f / sum;
    f32x4 o[4];
#pragma unroll
    for (int dt = 0; dt < 4; ++dt) o[dt] = (f32x4){0.f, 0.f, 0.f, 0.f};
#pragma unroll
    for (int kp = 0; kp < 5; ++kp) {
        union { u32x4 u; bf16x8 b; } pf;
        pf.u.x = cvt_pk_bf16(s[2 * kp][0], s[2 * kp][1]); pf.u.y = cvt_pk_bf16(s[2 * kp][2], s[2 * kp][3]);
        pf.u.z = cvt_pk_bf16(s[2 * kp + 1][0], s[2 * kp + 1][1]); pf.u.w = cvt_pk_bf16(s[2 * kp + 1][2], s[2 * kp + 1][3]);
#pragma unroll
        for (int dt = 0; dt < 4; ++dt) {
            LAS const unsigned char* vr = Vt + (dt * 16 + j) * VROW + ((kt0 + 2 * kp) * 16 + g * 4) * 2;
            const u32x2 lo = *(LAS const u32x2*)vr, hi = *(LAS const u32x2*)(vr + 32);
            union { u32x4 u; bf16x8 b; } vf; vf.u.x = lo.x; vf.u.y = lo.y; vf.u.z = hi.x; vf.u.w = hi.y;
            o[dt] = __builtin_amdgcn_mfma_f32_16x16x32_bf16(vf.b, pf.b, o[dt], 0, 0, 0);
        }
        __builtin_amdgcn_sched_barrier(0);
    }
#pragma unroll
    for (int dt = 0; dt < 4; ++dt) {
        u32x2 w; w.x = cvt_pk_bf16(o[dt].x * inv, o[dt].y * inv); w.y = cvt_pk_bf16(o[dt].z * inv, o[dt].w * inv);
        *(u32x2*)(optr + dt * 16 + g * 4) = w;
    }
}

__device__ __forceinline__ void phase_attn(const Params& P, int j, LAS unsigned char* lds, int wv) {
    const int tid = opaque_tid(wv), lane = tid & 63, wave = __builtin_amdgcn_readfirstlane(tid >> 6);
    unsigned char* ws = opaque_p(P.ws);
    const bf16_t* KVB = (const bf16_t*)(ws + WS_KVB); const bf16_t* Q = (const bf16_t*)(ws + WS_MIX + MIX_GG); bf16_t* O = (bf16_t*)(ws + WS_MIX + MIX_XR);
    const float* sinks = opaque_p(opaque_p(P.in[25]) + opaque_s(j) * 16); const bf16_t* CKB = (const bf16_t*)(ws + WS_CKB);
    LAS unsigned char* Ks = lds; LAS unsigned char* Vt = lds + VT_OFF;
    for (int u = opaque_s((int)blockIdx.x); u < 512; u += opaque_s((int)gridDim.x)) {
        __syncthreads();
        if (u < 256) {
            const int b = u >> 6, qb = (u >> 1) & 31, kh = u & 1;
            const int pos0 = qb * 128 - 144;
#pragma unroll 2
            for (int idx = tid; idx < 272 * 8; idx += NTHR) {
                const int i = idx >> 3, c = idx & 7, pos = pos0 + i;
                u32x4 kv = (u32x4){0u, 0u, 0u, 0u}, vv = kv;
                if (pos >= 0) { const bf16_t* r = KVB + (size_t)(b * SEQ + pos) * 256 + kh * 64 + c * 8; kv = *(const u32x4*)r; vv = *(const u32x4*)(r + 128); }
                *(LAS u32x4*)(Ks + i * KROW + c * 16) = kv;
                LAS unsigned short* vt = (LAS unsigned short*)(Vt + (c * 8) * VROW + i * 2);
                vt[0 * (VROW / 2)] = (unsigned short)(vv.x & 0xffff); vt[1 * (VROW / 2)] = (unsigned short)(vv.x >> 16);
                vt[2 * (VROW / 2)] = (unsigned short)(vv.y & 0xffff); vt[3 * (VROW / 2)] = (unsigned short)(vv.y >> 16);
                vt[4 * (VROW / 2)] = (unsigned short)(vv.z & 0xffff); vt[5 * (VROW / 2)] = (unsigned short)(vv.z >> 16);
                vt[6 * (VROW / 2)] = (unsigned short)(vv.w & 0xffff); vt[7 * (VROW / 2)] = (unsigned short)(vv.w >> 16);
            }
            __syncthreads();
            const int h = kh * 8 + wave; const float slope = exp2f(-0.5f * (float)(h + 1)), sink = sinks[h];
            const int jq = lane & 15, g = lane >> 4;
#pragma unroll 1
            for (int qt = 0; qt < 8; ++qt) {
                const int q0 = qb * 128 + qt * 16, qpos = q0 + jq; const size_t row = (size_t)b * SEQ + qpos;
                attn_tile(Ks, Vt, qt, Q + row * D + h * 64, O + row * D + h * 64, slope, sink, 144 + jq - 4 * g, qpos < 127 ? qpos : 127, lane);
            }
        } else {
            const int v = u - 256, s = v >> 1, kh = v & 1;
#pragma unroll 1
            for (int idx = tid; idx < 160 * 8; idx += NTHR) {
                const int i = idx >> 3, c = idx & 7;
                u32x4 kv = (u32x4){0u, 0u, 0u, 0u}, vv = kv;
                if (i < 128) {
                    const bf16_t* kr = CKB + (((size_t)s * 128 + i) * 2 + kh) * 64 + c * 8;
                    kv = *(const u32x4*)kr; vv = *(const u32x4*)(kr + (size_t)DB * 16384);
                } else if (i < 136) { const bf16_t* r = KVB + (size_t)(MP + s * 8 + (i - 128)) * 256 + kh * 64 + c * 8; kv = *(const u32x4*)r; vv = *(const u32x4*)(r + 128); }
                *(LAS u32x4*)(Ks + i * KROW + c * 16) = kv;
                LAS unsigned short* vt = (LAS unsigned short*)(Vt + (c * 8) * VROW + i * 2);
                vt[0 * (VROW / 2)] = (unsigned short)(vv.x & 0xffff); vt[1 * (VROW / 2)] = (unsigned short)(vv.x >> 16);
                vt[2 * (VROW / 2)] = (unsigned short)(vv.y & 0xffff); vt[3 * (VROW / 2)] = (unsigned short)(vv.y >> 16);
                vt[4 * (VROW / 2)] = (unsigned short)(vv.z & 0xffff); vt[5 * (VROW / 2)] = (unsigned short)(vv.z >> 16);
                vt[6 * (VROW / 2)] = (unsigned short)(vv.w & 0xffff); vt[7 * (VROW / 2)] = (unsigned short)(vv.w >> 16);
            }
            __syncthreads();
            if (wave < 4) {
                const int jq = lane & 15, g = lane >> 4, h = kh * 8 + wave * 2 + (jq >> 3), i = jq & 7;
                const float slope = exp2f(-0.5f * (float)(h + 1)), sink = sinks[h];
                const size_t row = (size_t)MP + s * 8 + i;
                attn_tile(Ks, Vt, 0, Q + row * D + h * 64, O + row * D + h * 64, slope, sink, 128 + i - 4 * g, 127, lane);
            }
        }
    }
    __syncthreads();
}

constexpr size_t MIX_PART = 100663296;
__device__ __forceinline__ void phase_reduce(const Params& P, int nres_next, int wv) {
    const int tid = opaque_tid(wv), lane = tid & 63, wave = tid >> 6;
    unsigned char* ws = opaque_p(P.ws);
    float* X = opaque_p(P.out) + O_X; bf16_t* XB = (bf16_t*)(ws + WS_XB); float* SSn = (float*)(ws + WS_SSP) + (size_t)nres_next * M * 16;
    const float* PART = (const float*)(ws + WS_MIX + MIX_PART);
    for (int r = opaque_s((int)blockIdx.x) * 8 + wave; r < MS; r += opaque_s((int)gridDim.x) * 8) {
        const int row = MP + r; float s = 0.f;
        u32x2 o[4]; f32x4 a[4];
#pragma unroll
        for (int j = 0; j < 4; ++j) {
            const size_t c = (size_t)j * 256 + lane * 4;
            o[j] = *(const u32x2*)(XB + (size_t)row * D + c);
            a[j] = *(const f32x4*)(PART + (size_t)r * D + c);
#pragma unroll
            for (int kc = 1; kc < 6; ++kc) a[j] = a[j] + *(const f32x4*)(PART + ((size_t)kc * MS + r) * D + c);
        }
#pragma unroll
        for (int j = 0; j < 4; ++j) {
            const size_t c = (size_t)j * 256 + lane * 4;
            f32x4 v = (f32x4){bf_lo(o[j].x), bf_hi(o[j].x), bf_lo(o[j].y), bf_hi(o[j].y)}; v = v + a[j] * 0.5f;
            u32x2 w; w.x = cvt_pk_bf16(v.x, v.y); w.y = cvt_pk_bf16(v.z, v.w);
            *(u32x2*)(XB + (size_t)row * D + c) = w;
            v = (f32x4){bf_lo(w.x), bf_hi(w.x), bf_lo(w.y), bf_hi(w.y)};
            s += (v.x * v.x + v.y * v.y) + (v.z * v.z + v.w * v.w);
        }
#pragma unroll
        for (int o2 = 1; o2 < 64; o2 <<= 1) s += __shfl_xor(s, o2);
        if (lane < 16) SSn[(size_t)row * 16 + lane] = lane == 0 ? s : 0.f;
    }
}

__device__ __forceinline__ void phase_final(const Params& P, int wv) {
    const int tid = opaque_tid(wv), lane = tid & 63, wave = tid >> 6;
    float* X = P.out + O_X; const bf16_t* XB = (const bf16_t*)(P.ws + WS_XB); const float* ss = (const float*)(P.ws + WS_SSP) + 12 * (size_t)M * 16; const float* g = P.in[27];
    f32x4 gv[4];
#pragma unroll
    for (int j = 0; j < 4; ++j) gv[j] = *(const f32x4*)(g + j * 256 + lane * 4);
    const int nwv = opaque_s((int)gridDim.x) * 8;
    for (int row = opaque_s((int)blockIdx.x) * 8 + wave; row < M; row += 2 * nwv) {
        const int row2 = row + nwv; const bool has2 = row2 < M; const int r2 = has2 ? row2 : row;
        const float rs = rstd_of(ss, row), rs2 = rstd_of(ss, r2);
        u32x2 o[4], o2[4];
#pragma unroll
        for (int j = 0; j < 4; ++j) { o[j] = *(const u32x2*)(XB + (size_t)row * D + j * 256 + lane * 4); o2[j] = *(const u32x2*)(XB + (size_t)r2 * D + j * 256 + lane * 4); }
#pragma unroll
        for (int j = 0; j < 4; ++j) {
            const f32x4 v = (f32x4){bf_lo(o[j].x), bf_hi(o[j].x), bf_lo(o[j].y), bf_hi(o[j].y)}; *(f32x4*)(X + (size_t)row * D + j * 256 + lane * 4) = v * rs * gv[j];
            if (has2) { const f32x4 v2 = (f32x4){bf_lo(o2[j].x), bf_hi(o2[j].x), bf_lo(o2[j].y), bf_hi(o2[j].y)}; *(f32x4*)(X + (size_t)row2 * D + j * 256 + lane * 4) = v2 * rs2 * gv[j]; }
        }
    }
}

#define XB_TMO      128
#define XB_XCNT(j)  (256  + 64 * (j))
#define XB_XSUB(j)  (1280 + 64 * (j))
#define XB_XGEN(j)  (2304 + 64 * (j))
#define XB_TOP      3328
#define XB_TOPGEN   3392
#define XCD_BAR_WORDS 3456
#define XB_SPIN_CAP (1u << 20)
__device__ __forceinline__ unsigned xb_ld(unsigned* p)              { return __hip_atomic_load(p, __ATOMIC_RELAXED, __HIP_MEMORY_SCOPE_AGENT); }
__device__ __forceinline__ unsigned xb_add(unsigned* p, unsigned v) { return __hip_atomic_fetch_add(p, v, __ATOMIC_RELAXED, __HIP_MEMORY_SCOPE_AGENT); }
__device__ __forceinline__ unsigned xb_xcc_id() { return (unsigned)__builtin_amdgcn_s_getreg((3 << 11) | 20) & 0xFu; }
#define XB_SPIN(cond, bar) do { unsigned _sp = 0; while (cond) { __builtin_amdgcn_s_sleep(1); \
    if ((++_sp & 255u) == 0u) { if (xb_ld(&(bar)[XB_TMO])) break; if (_sp > XB_SPIN_CAP) { atomicAdd(&(bar)[XB_TMO], 1u); break; } } } } while (0)
struct XcdBarrier { unsigned* bar; unsigned x; volatile LAS unsigned* st; };
__device__ __forceinline__ XcdBarrier xcd_barrier_post(unsigned* bar, volatile LAS unsigned* st) {
    XcdBarrier b; b.bar = bar; b.x = xb_xcc_id(); b.st = st;
    if (threadIdx.x == 0) (void)xb_add(&bar[XB_XCNT(b.x)], 1u);
    return b;
}
__device__ __forceinline__ void xcd_barrier_complete(unsigned* bar, unsigned x, unsigned& nloc, unsigned& nx) {
    const unsigned G = gridDim.x * gridDim.y * gridDim.z;
    unsigned sum, cnt, mine, sp = 0u;
    for (;;) {
        sum = 0u; cnt = 0u; mine = 0u;
#pragma unroll
        for (unsigned j = 0; j < 16; ++j) { const unsigned c = xb_ld(&bar[XB_XCNT(j)]); sum += c; cnt += (c > 0u) ? 1u : 0u; mine = (j == x) ? c : mine; }
        if (sum == G) break;
        __builtin_amdgcn_s_sleep(1);
        if ((++sp & 255u) == 0u) { if (xb_ld(&bar[XB_TMO])) break; if (sp > XB_SPIN_CAP) { atomicAdd(&bar[XB_TMO], 1u); break; } }
    }
    nloc = mine > 0u ? mine : 1u; nx = cnt > 0u ? cnt : 1u;
}
__device__ __forceinline__ void xcd_barrier(unsigned* bar, unsigned x, volatile LAS unsigned* st, int wv) {
    asm volatile("s_waitcnt vmcnt(0)" ::: "memory");
    __syncthreads();
    if (opaque_tid(wv) == 0) {
        __builtin_amdgcn_s_waitcnt(0);
        unsigned nloc = st[0], nx = st[1];
        if (nloc == 0u) { xcd_barrier_complete(bar, x, nloc, nx); st[0] = nloc; st[1] = nx; }
        const unsigned old = xb_add(&bar[XB_XSUB(x)], 1u);
        const unsigned gen = old / nloc;
        if (old + 1u == (gen + 1u) * nloc) {
            __builtin_amdgcn_fence(__ATOMIC_RELEASE, "agent");
            asm volatile("s_waitcnt vmcnt(0)" ::: "memory");
            asm volatile("buffer_inv sc1" ::: "memory");
            const unsigned og = xb_add(&bar[XB_TOP], 1u);
            const unsigned tg = og / nx;
            if (og + 1u == (tg + 1u) * nx) xb_add(&bar[XB_TOPGEN], 1u);
            else XB_SPIN(xb_ld(&bar[XB_TOPGEN]) == tg, bar);
            xb_add(&bar[XB_XGEN(x)], 1u);
            asm volatile("s_waitcnt vmcnt(0)" ::: "memory");
        } else {
            asm volatile("buffer_inv sc1" ::: "memory");
            XB_SPIN(xb_ld(&bar[XB_XGEN(x)]) == gen, bar);
            asm volatile("s_waitcnt vmcnt(0)" ::: "memory");
        }
    }
    __syncthreads();
}

constexpr int N_PHASES = 45;
constexpr int LDS_BYTES = 131072 + 64 + 1024;
__global__ void __launch_bounds__(NTHR, 2) yoco_fwd(Params P) {
    extern __shared__ __attribute__((aligned(16))) unsigned char lds_raw[];
    LAS unsigned char* lds = (LAS unsigned char*)lds_raw;
    cg::grid_group grid = cg::this_grid();
    const int wv = __builtin_amdgcn_readfirstlane((int)(threadIdx.x >> 6));
    int ph = 0, nres = 0;
    volatile LAS unsigned* bst = (volatile LAS unsigned*)(lds + 131072);
    if (threadIdx.x < 16) bst[threadIdx.x] = 0u;
    __syncthreads();
    unsigned* barw = (unsigned*)(P.ws + WS_BAR);
    const unsigned xcc = P.hi - P.lo > 1 ? xcd_barrier_post(barw, bst).x : 0u;
    if (P.hi > 100000) grid.sync();
#define ON() (ph >= P.lo && ph < P.hi)
#define PV() const int G = opaque_s((int)gridDim.x), bid = opaque_s((int)blockIdx.x); unsigned char* ws = opaque_p(P.ws); float* X = opaque_p(P.out); bf16_t* XB = (bf16_t*)(ws + WS_XB); float* SS = (float*)(ws + WS_SSP); \
    bf16_t* W = (bf16_t*)(ws + WS_W); unsigned char* MIX = ws + WS_MIX; (void)G; (void)bid; (void)X; (void)XB; (void)SS; (void)W; (void)MIX
#define SEAM() do { if (ph >= P.lo && ph + 1 < P.hi) xcd_barrier(opaque_p(barw), opaque_s((int)xcc), bst, wv); ++ph; } while (0)

    if (ON()) phase_prep(P, lds, wv);
    SEAM();
    for (int l = 0; l < 4; ++l) {
        for (int f = 0; f < 2; ++f) {
            if (f == 1) {
                if (l < 2) {
                    if (ON()) { PV(); pg8::Gemm g{XB, W + W_IN + (size_t)l * 2048 * D, D, D, D, M / 256, 8, 0}; pg8::StaticOrder S; S.init(M / 256, 8, G, bid);
                        EpiRgIn E{(bf16_t*)(MIX + MIX_GG), (bf16_t*)(MIX + MIX_XR), SS + (size_t)nres * M * 16, (LAS float*)(lds + RS_OFF)}; pg8::gemm_phase(lds, g, S, E, wv); }
                    SEAM();
                    if (ON()) phase_conv(P, l, wv);
                    SEAM();
                    if (ON()) { PV(); pg8::Gemm g{(const bf16_t*)(MIX + MIX_XC), W + W_G + (size_t)l * 2048 * 256, D, 256, 256, M / 256, 8, 1}; pg8::StaticOrder S; S.init(M / 256, 8, G, bid);
                        EpiGates E{MIX, (const float*)(ws + WS_SPT) + l * 3 * D}; pg8::gemm_phase(lds, g, S, E, wv); }
                    SEAM();
                    if (ON()) phase_scan1(P, wv);
                    SEAM();
                    if (ON()) phase_scan3(P, l, wv);
                    SEAM();
                    if (ON()) { PV(); pg8::Gemm g{(const bf16_t*)(MIX + MIX_XC), W + W_OUT + (size_t)l * D * D, D, D, D, M / 256, 4, 0}; pg8::StaticOrder S; S.init(M / 256, 4, G, bid);
                        EpiResid E{X, XB, SS + (size_t)(nres + 1) * M * 16, 1.f, nullptr}; pg8::gemm_phase(lds, g, S, E, wv); }
                    SEAM(); ++nres;
                } else {
                    const int j = opaque_s(opaque_s(l) - 2);
                    if (ON()) { PV(); pg8::Gemm g{XB, W + W_Q + (size_t)j * D * D, D, D, D, M / 256, 4, 0}; pg8::StaticOrder S; S.init(M / 256, 4, G, bid);
                        EpiQ E{(bf16_t*)(MIX + MIX_GG), SS + (size_t)nres * M * 16, (LAS float*)(lds + RS_OFF)}; pg8::gemm_phase(lds, g, S, E, wv); }
                    SEAM();
                    if (ON()) phase_attn(P, j, lds, wv);
                    SEAM();
                    if (ON()) { PV(); pg8::Gemm g{(const bf16_t*)(MIX + MIX_XR), W + W_O + (size_t)j * D * D, D, D, D, M / 256, 4, 0}; pg8::StaticOrder S; S.init(M / 256, 4, G, bid);
                        EpiResid E{X, XB, SS + (size_t)(nres + 1) * M * 16, 1.f, nullptr}; pg8::gemm_phase(lds, g, S, E, wv); }
                    SEAM(); ++nres;
                }
            }
            if (ON()) { PV(); pg8::Gemm g{XB, W + W_GU + (size_t)(l * 2 + f) * NGU * D, D, D, D, M / 256, NGU / 256, 0}; pg8::StaticOrder S; S.init(M / 256, NGU / 256, G, bid);
                EpiSwiGLU E{(bf16_t*)(MIX + MIX_GG), SS + (size_t)nres * M * 16, (LAS float*)(lds + RS_OFF)}; pg8::gemm_phase(lds, g, S, E, wv); }
            SEAM();
            if (ON()) { PV(); pg8::Gemm g{(const bf16_t*)(MIX + MIX_GG), W + W_D + (size_t)(l * 2 + f) * D * DFF, DFF, DFF, DFF, M / 256, 4, 0}; pg8::DownOrder S; S.init(G, bid);
                EpiResid E{X, XB, SS + (size_t)(nres + 1) * M * 16, 0.5f, (float*)(MIX + MIX_PART)}; pg8::gemm_phase(lds, g, S, E, wv); }
            SEAM();
            if (ON()) phase_reduce(P, nres + 1, wv);
            SEAM(); ++nres;
        }
        if (l == 1) {
            if (ON()) { PV(); pg8::Gemm g{XB, W + W_KV, D, D, D, M / 256, 1, 0}; pg8::StaticOrder S; S.init(M / 256, 1, G, bid);
                EpiKV E{(bf16_t*)(ws + WS_KVB), X, SS + (size_t)nres * M * 16, (LAS float*)(lds + RS_OFF)}; pg8::gemm_phase(lds, g, S, E, wv); }
            SEAM();
        }
    }
    if (ON()) phase_final(P, wv);
#undef ON
#undef SEAM
}

extern "C" void kernel_launch(void* const* d_in, const int* in_sizes, int n_in, void* d_out, int out_size, void* d_ws, size_t ws_size, hipStream_t stream) {
    static int grid = 0;
    if (grid == 0) {
        if (n_in != 28 || (size_t)out_size != OUT_TOTAL || ws_size < WS_END) { fprintf(stderr, "kernel_launch: unexpected shapes (n_in %d out %d ws %zu need %zu)\n", n_in, out_size, ws_size, (size_t)WS_END); grid = -1; return; }
        int dev = 0, cus = 0, per_cu = 0;
        hipGetDevice(&dev); hipDeviceGetAttribute(&cus, hipDeviceAttributeMultiprocessorCount, dev);
        if (hipFuncSetAttribute((const void*)yoco_fwd, hipFuncAttributeMaxDynamicSharedMemorySize, LDS_BYTES) != hipSuccess) { fprintf(stderr, "kernel_launch: hipFuncSetAttribute failed\n"); grid = -1; return; }
        hipOccupancyMaxActiveBlocksPerMultiprocessor(&per_cu, (const void*)yoco_fwd, NTHR, LDS_BYTES);
        (void)hipGetLastError();
        if (per_cu < 1) per_cu = 1;
        grid = cus;
        fprintf(stderr, "kernel_launch: cus %d per_cu %d grid %d\n", cus, per_cu, grid);
    }
    if (grid < 0) return;
    if (hipMemsetAsync((char*)d_ws + WS_BAR, 0, 16384, stream) != hipSuccess) { fprintf(stderr, "kernel_launch: memset failed\n"); return; }
    Params p{};
    for (int i = 0; i < 28; ++i) p.in[i] = (const float*)d_in[i];
    p.out = (float*)d_out; p.ws = (unsigned char*)d_ws;
#if N_LAUNCH_MODE == 1
#ifndef DBG_LAST_PHASE
#define DBG_LAST_PHASE (N_PHASES - 1)
#endif
    for (int i = 0; i < N_PHASES; ++i) { if (i > DBG_LAST_PHASE && i != N_PHASES - 1) continue; p.lo = i; p.hi = i + 1; hipLaunchKernelGGL(yoco_fwd, dim3(grid), dim3(NTHR), LDS_BYTES, stream, p); }
#else
    p.lo = 0; p.hi = N_PHASES;
    void* args[] = {&p};
    hipError_t e = hipLaunchCooperativeKernel((const void*)yoco_fwd, dim3(grid), dim3(NTHR), args, LDS_BYTES, stream);
    if (e != hipSuccess) fprintf(stderr, "cooperative launch failed: %s (grid %d)\n", hipGetErrorString(e), grid);
#endif
}
```

```cpp
#include <hip/hip_runtime.h>
#include <hip/hip_cooperative_groups.h>
#include <cstdio>
#include <cstdint>
namespace cg = cooperative_groups;

#ifndef N_LAUNCH_MODE
#define N_LAUNCH_MODE 0
#endif

#define LAS __attribute__((address_space(3)))
#define GAS __attribute__((address_space(1)))
typedef unsigned short bf16_t;
typedef short bf16x8 __attribute__((ext_vector_type(8)));
typedef float f32x4 __attribute__((ext_vector_type(4)));
typedef float f32x2 __attribute__((ext_vector_type(2)));
typedef unsigned u32x4 __attribute__((ext_vector_type(4)));
typedef unsigned u32x2 __attribute__((ext_vector_type(2)));
typedef _Float16 h16x8 __attribute__((ext_vector_type(8)));
typedef _Float16 h16x2 __attribute__((ext_vector_type(2)));

constexpr int D = 1024, DFF = 2816, NGU = 5632;
constexpr int MP = 16384, MS = 1024, M = MP + MS;
constexpr int SEQ = 4096, NSEQ = 4, DB = 128, DS = 8;
constexpr int NTHR = 512;
constexpr float EPS = 1e-6f;

constexpr size_t O_X = 0;
constexpr size_t O_PH = 17825792, O_PC = O_PH + 8192, O_PK = O_PC + 24576, O_PV = O_PK + 65536;
constexpr size_t O_SH = O_PV + 65536, O_SC = O_SH + 262144, O_SK = O_SC + 786432, O_SV = O_SK + 2097152;
constexpr size_t OUT_TOTAL = O_SV + 2097152;

constexpr size_t WS_SS = 0;
constexpr size_t WS_SPT = 917504;
constexpr size_t WS_CARRY = 1048576;
constexpr size_t WS_KVB = WS_CARRY + 2097152;
constexpr size_t WS_XB = WS_KVB + (size_t)M * 256 * 2;
constexpr size_t WS_MIX = WS_XB + (size_t)M * D * 2;
constexpr size_t MIX_GG = 0;
constexpr size_t MIX_XR = (size_t)M * D * 2;
constexpr size_t MIX_U = MIX_XR + (size_t)M * D * 2;
constexpr size_t MIX_XC = MIX_XR + (size_t)M * D * 4;
constexpr size_t MIX_BYTES = MIX_XC + (size_t)M * D * 2;
constexpr size_t WS_W = WS_MIX + MIX_BYTES;
constexpr size_t W_GU = 0, W_D = W_GU + 8ull * NGU * D, W_IN = W_D + 8ull * D * DFF, W_OUT = W_IN + 2ull * 2048 * D;
constexpr size_t W_KV = W_OUT + 2ull * D * D, W_Q = W_KV + 256ull * D, W_O = W_Q + 2ull * D * D, W_G = W_O + 2ull * D * D;
constexpr size_t W_END = W_G + 2ull * 2048 * 256;
constexpr size_t WS_SSP = WS_W + W_END * 2;
constexpr size_t WS_CKB = WS_SSP + 13ull * M * 16 * 4;
constexpr size_t WS_BAR = WS_CKB + 2ull * DB * 128 * 128 * 2;
constexpr size_t WS_END = WS_BAR + 16384;

struct Params { const float* in[28]; float* out; unsigned char* ws; int lo, hi; };

__device__ __forceinline__ unsigned cvt_pk_bf16(float lo, float hi) { unsigned r; asm volatile("v_cvt_pk_bf16_f32 %0, %1, %2" : "=v"(r) : "v"(lo), "v"(hi)); return r; }
__device__ __forceinline__ void st16_wt(void* p, u32x4 v) { asm volatile("global_store_dwordx4 %0, %1, off sc1\n\ts_nop 1" :: "v"(p), "v"(v) : "memory"); }
__device__ __forceinline__ float bf_lo(unsigned w) { return __uint_as_float(w << 16); }
__device__ __forceinline__ float bf_hi(unsigned w) { return __uint_as_float(w & 0xffff0000u); }
__device__ __forceinline__ float fast_rcp(float x) { return __builtin_amdgcn_rcpf(x); }
__device__ __forceinline__ float sigmoidf_(float x) { return fast_rcp(1.f + __expf(-x)); }
__device__ __forceinline__ float silu_(float x) { return x * sigmoidf_(x); }
__device__ __forceinline__ float gelu_tanh_(float x) { return x * sigmoidf_(1.5957691216f * (x + 0.044715f * x * x * x)); }
__device__ __forceinline__ float rstd_of(const float* ssp, int row) { const GAS f32x4* p = (const GAS f32x4*)(ssp + (size_t)row * 16); const f32x4 a = p[0], b = p[1], c = p[2], d = p[3];
    const float ss = ((a.x + a.y) + (a.z + a.w)) + ((b.x + b.y) + (b.z + b.w)) + ((c.x + c.y) + (c.z + c.w)) + ((d.x + d.y) + (d.z + d.w)); return rsqrtf(ss * (1.f / D) + EPS); }
constexpr int RS_OFF = 131072 + 64;
#define GASP __attribute__((address_space(1)))
__device__ __forceinline__ void rstd_prefetch(f32x4 (&pf)[4], const float* ssp, int pm, int tid) {
    if (tid < 256) { const GASP f32x4* p = (const GASP f32x4*)(ssp + (size_t)(pm * 256 + tid) * 16); pf[0] = p[0]; pf[1] = p[1]; pf[2] = p[2]; pf[3] = p[3]; }
}
__device__ __forceinline__ void unit_rstd(const f32x4 (&pf)[4], LAS float* rsl, int tid) {
    if (tid < 256) { const f32x4 a = pf[0], b = pf[1], c = pf[2], d = pf[3];
        const float ss = ((a.x + a.y) + (a.z + a.w)) + ((b.x + b.y) + (b.z + b.w)) + ((c.x + c.y) + (c.z + c.w)) + ((d.x + d.y) + (d.z + d.w)); rsl[tid] = rsqrtf(ss * (1.f / D) + EPS); }
    asm volatile("s_waitcnt lgkmcnt(0)" ::: "memory"); __builtin_amdgcn_s_barrier(); asm volatile("" ::: "memory");
}
__device__ __forceinline__ int opaque_s(int x) { asm volatile("" : "+s"(x)); return x; }
template <class T> __device__ __forceinline__ T* opaque_p(T* p) { asm volatile("" : "+s"(p)); return p; }
__device__ __forceinline__ int opaque_tid(int wv) { unsigned z = 0u; asm volatile("" : "+s"(z)); int t = opaque_s(wv) * 64 + (int)__builtin_amdgcn_mbcnt_hi(~0u, __builtin_amdgcn_mbcnt_lo(~0u, z)); asm volatile("" : "+v"(t)); return t; }

namespace pg8 {
constexpr int BM = 256, BK = 64, HALF = 128, HTB = HALF * BK * 2, STAGE_BYTES = 8 * HTB, NXCD = 8, WGM = 8;
__host__ __device__ __forceinline__ int lds_byte(int r, int c) { const int st = (r >> 4) * 2 + (c >> 5), rr = r & 15, cc = c & 31, ob = rr * 64 + cc * 2; return st * 1024 + (ob ^ (((ob >> 9) & 1) << 5)); }
__host__ __device__ __forceinline__ void stage_rc(int b, int& R, int& C) { const int st = b / 1024, sb = b % 1024, swz = sb ^ (((sb >> 9) & 1) << 5); R = (st >> 1) * 16 + swz / 64; C = (st & 1) * 32 + (swz % 64) / 2; }
__host__ __device__ __forceinline__ int perm32(int rho) { const int n = rho >> 4, i = rho & 15; return 8 * (i >> 2) + 4 * n + (i & 3); }

struct Unit { int pm, pn, kc; };
struct Gemm { const bf16_t* A; const bf16_t* Bt; int lda, ldb, K, nM, nN, ablk; };

struct StaticOrder {
    int nM, nN, nwg, G, c;
    __device__ void init(int nM_, int nN_, int G_, int c_) { nM = nM_; nN = nN_; nwg = nM * nN; G = G_; c = c_; }
    static constexpr bool SPLIT = false;
    __device__ bool next(int i, Unit& u) const {
        const long L = (long)i * G + c; if (L >= nwg) return false;
        u.kc = -1;
        int wgid = (int)L; { const int q = nwg / NXCD, r = nwg % NXCD, xcd = wgid % NXCD, off = wgid / NXCD; wgid = (xcd < r ? xcd * (q + 1) : r * (q + 1) + (xcd - r) * q) + off; }
        const int nig = WGM * nN, gid = wgid / nig, fm = gid * WGM, gsz = (nM - fm) < WGM ? (nM - fm) : WGM;
        u.pm = fm + ((wgid % nig) % gsz); u.pn = (wgid % nig) / gsz; return true;
    }
};

struct DownOrder {
    int G, c;
    static constexpr bool SPLIT = true;
    __device__ void init(int G_, int c_) { G = G_; c = c_; }
    __device__ bool next(int i, Unit& u) const {
        const int L = i * G + c; if (L >= 256 + 96) return false;
        const bool full = L < 256; const int r = L >> 3, idx = L - 256, tile = idx / 6;
        const int pm = full ? (L & 7) * 8 + (r & 7) : 64 + (tile >> 2), pn = full ? (r >> 3) : (tile & 3), kc = full ? -1 : idx - tile * 6;
        u.pm = pm; u.pn = pn; u.kc = kc;
        return true;
    }
};

template <class Epi, class Sched>
__device__ __forceinline__ void gemm_phase(LAS unsigned char* lds, const Gemm g, const Sched& S, const Epi& E, int wv) {
    const int tid = opaque_tid(wv), wid = __builtin_amdgcn_readfirstlane(tid >> 6), lane = tid & 63, wr = wid >> 2, wc = wid & 3, fr = lane & 15, fq = lane >> 4;
    const int K = opaque_s(g.K), nt = K / BK;
    unsigned voffA[2], voffB[2];
#pragma unroll
    for (int i = 0; i < 2; ++i) { int R, C; stage_rc(tid * 16 + i * 8192, R, C); const int Rb = (R & ~31) + perm32(R & 31);
        voffA[i] = (unsigned)(R * g.lda + C) * 2u; voffB[i] = (unsigned)(Rb * g.ldb + C) * 2u; }
    const size_t kstep = (size_t)(BK * 2);
    const size_t hstepA = (size_t)HALF * g.lda * 2, hstepB = (size_t)HALF * g.ldb * 2;
    const unsigned ldsw = (unsigned)wid * 1024u;
    const int aoff = lds_byte(wr * 64 + fr, fq * 8), boff = lds_byte(wc * 32 + fr, fq * 8);
#define PG8_SA(b, h) (((b) * 2 + (h)) * HTB)
#define PG8_SB(b, h) ((4 + (b) * 2 + (h)) * HTB)
#define PG8_STAGE(bufoff, gbase, voff) do { _Pragma("unroll") for (int _i = 0; _i < 2; ++_i) \
        __builtin_amdgcn_global_load_lds((const unsigned*)((const char*)(gbase) + (voff)[_i]), (LAS unsigned*)(lds + (bufoff) + ldsw + _i * 8192), 16, 0, 0); } while (0)
#define PG8_LDA(dst, b, h) do { _Pragma("unroll") for (int m = 0; m < 4; ++m) _Pragma("unroll") for (int k = 0; k < 2; ++k) dst[m][k] = *(const LAS bf16x8*)(lds + PG8_SA(b, h) + aoff + m * 2048 + k * 1024); } while (0)
#define PG8_LDB(dst, b, h) do { _Pragma("unroll") for (int n = 0; n < 2; ++n) _Pragma("unroll") for (int k = 0; k < 2; ++k) dst[n][k] = *(const LAS bf16x8*)(lds + PG8_SB(b, h) + boff + n * 2048 + k * 1024); } while (0)
#define PG8_MMA(ai, bj, At, Bt) do { __builtin_amdgcn_s_setprio(1); _Pragma("unroll") for (int m = 0; m < 4; ++m) _Pragma("unroll") for (int n = 0; n < 2; ++n) _Pragma("unroll") for (int k = 0; k < 2; ++k) \
        acc[ai][bj][m][n] = __builtin_amdgcn_mfma_f32_16x16x32_bf16(Bt[n][k], At[m][k], acc[ai][bj][m][n], 0, 0, 0); __builtin_amdgcn_s_setprio(0); } while (0)
#define PG8_WAIT_V(n) asm volatile("s_waitcnt vmcnt(" #n ")" ::: "memory")
#define PG8_WAIT_L(n) asm volatile("s_waitcnt lgkmcnt(" #n ")" ::: "memory")
#define PG8_BAR __builtin_amdgcn_s_barrier()
#define PG8_SCHED __builtin_amdgcn_sched_barrier(0)
#define PG8_KOFF(u) ((Sched::SPLIT && (u).kc > 0) ? (size_t)(u).kc * 1024 : (size_t)0)
#define PG8_ABASE(u) ((const char*)g.A + (size_t)(u).pm * 2 * hstepA + (g.ablk ? (size_t)((u).pn >> 1) * 512 : 0) + PG8_KOFF(u))
#define PG8_BBASE(u) ((const char*)g.Bt + (size_t)(u).pn * 2 * hstepB + PG8_KOFF(u))
#define PG8_NT(u) ((Sched::SPLIT && (u).kc >= 0) ? ((u).kc < 5 ? 8 : 4) : nt)
    Unit cur, nxt; int ui = 0;
    if (!S.next(0, cur)) return;
    f32x4 acc[2][2][4][2];
#pragma unroll
    for (int a = 0; a < 2; ++a)
#pragma unroll
        for (int b = 0; b < 2; ++b)
#pragma unroll
            for (int m = 0; m < 4; ++m)
#pragma unroll
                for (int n = 0; n < 2; ++n) acc[a][b][m][n] = (f32x4){0.f, 0.f, 0.f, 0.f};
    bf16x8 At[4][2], B0[2][2], B1[2][2];
    f32x4 pf[4] = {{0.f, 0.f, 0.f, 0.f}, {0.f, 0.f, 0.f, 0.f}, {0.f, 0.f, 0.f, 0.f}, {0.f, 0.f, 0.f, 0.f}};
    const char* cA = PG8_ABASE(cur); const char* cB = PG8_BBASE(cur);
    PG8_STAGE(PG8_SB(0, 0), cB, voffB); PG8_STAGE(PG8_SB(0, 1), cB + hstepB, voffB); PG8_STAGE(PG8_SA(0, 0), cA, voffA); PG8_STAGE(PG8_SA(0, 1), cA + hstepA, voffA);
    if (wr == 1) PG8_BAR;
    PG8_WAIT_V(2); PG8_BAR;
    PG8_STAGE(PG8_SB(1, 0), cB + kstep, voffB); PG8_STAGE(PG8_SA(1, 0), cA + kstep, voffA); PG8_STAGE(PG8_SB(1, 1), cB + hstepB + kstep, voffB);
    PG8_WAIT_V(6); PG8_BAR;
    for (;;) {
        const bool has_next = S.next(ui + 1, nxt);
        const char* nA = has_next ? PG8_ABASE(nxt) : cA; const char* nB = has_next ? PG8_BBASE(nxt) : cB;
        const int ntu = PG8_NT(cur);
#pragma unroll 1
        for (int t = 0; t < ntu; t += 2) {
            const bool last = (t == ntu - 2);
            if (last) E.prefetch(pf, cur, tid);
            const char* a1 = cA + (size_t)(t + 1) * kstep;
            const char* a2 = last ? nA : cA + (size_t)(t + 2) * kstep; const char* b2 = last ? nB : cB + (size_t)(t + 2) * kstep;
            const char* a3 = a2 + kstep; const char* b3 = b2 + kstep;
            PG8_LDB(B0, 0, 0); PG8_LDB(B1, 0, 1); PG8_SCHED; PG8_LDA(At, 0, 0); PG8_STAGE(PG8_SA(1, 1), a1 + hstepA, voffA);
            PG8_WAIT_V(8); PG8_WAIT_L(0); PG8_BAR; PG8_MMA(0, 0, At, B0); PG8_MMA(0, 1, At, B1); PG8_BAR; PG8_SCHED;
            PG8_LDA(At, 0, 1); PG8_STAGE(PG8_SB(0, 0), b2, voffB); PG8_STAGE(PG8_SB(0, 1), b2 + hstepB, voffB); PG8_STAGE(PG8_SA(0, 0), a2, voffA);
            PG8_WAIT_V(8); PG8_WAIT_L(0); PG8_BAR; PG8_MMA(1, 0, At, B0); PG8_MMA(1, 1, At, B1); PG8_BAR; PG8_SCHED;
            PG8_LDB(B0, 1, 0); PG8_LDB(B1, 1, 1); PG8_SCHED; PG8_LDA(At, 1, 0); PG8_STAGE(PG8_SA(0, 1), a2 + hstepA, voffA);
            PG8_WAIT_V(8); PG8_WAIT_L(0); PG8_BAR; PG8_MMA(0, 0, At, B0); PG8_MMA(0, 1, At, B1); PG8_BAR; PG8_SCHED;
            PG8_LDA(At, 1, 1); PG8_STAGE(PG8_SB(1, 0), b3, voffB); PG8_STAGE(PG8_SB(1, 1), b3 + hstepB, voffB); PG8_STAGE(PG8_SA(1, 0), a3, voffA);
            PG8_WAIT_V(8); PG8_WAIT_L(0); PG8_BAR; PG8_MMA(1, 0, At, B0); PG8_MMA(1, 1, At, B1); PG8_BAR; PG8_SCHED;
        }
        if (wr == 0) PG8_BAR;
        E(acc, cur, wr, wc, fr, fq, pf);
        if (!has_next) break;
#pragma unroll
        for (int a = 0; a < 2; ++a)
#pragma unroll
            for (int b = 0; b < 2; ++b)
#pragma unroll
                for (int m = 0; m < 4; ++m)
#pragma unroll
                    for (int n = 0; n < 2; ++n) acc[a][b][m][n] = (f32x4){0.f, 0.f, 0.f, 0.f};
        cur = nxt; cA = nA; cB = nB; ++ui;
        if (wr == 1) PG8_BAR;
    }
    PG8_WAIT_V(0);
    PG8_BAR;
#undef PG8_SA
#undef PG8_SB
#undef PG8_STAGE
#undef PG8_LDA
#undef PG8_LDB
#undef PG8_MMA
#undef PG8_WAIT_V
#undef PG8_WAIT_L
#undef PG8_BAR
#undef PG8_SCHED
#undef PG8_ABASE
#undef PG8_BBASE
#undef PG8_KOFF
#undef PG8_NT
}
}
using pg8::Unit; using pg8::HALF;

struct EpiSwiGLU {
    bf16_t* ACT; const float* ss; LAS float* rsl;
    __device__ __forceinline__ void prefetch(f32x4 (&pf)[4], const Unit& u, int tid) const { rstd_prefetch(pf, ss, u.pm, tid); }
    __device__ __forceinline__ void operator()(const f32x4 (&acc)[2][2][4][2], const Unit& u, int wr, int wc, int fr, int fq, const f32x4 (&pf)[4]) const {
        const int row0 = u.pm * 256 + wr * 64 + fr, col0 = u.pn * 128 + wc * 32 + 8 * fq;
        unit_rstd(pf, rsl, (wr * 4 + wc) * 64 + fq * 16 + fr);
        float rsv[2][4];
#pragma unroll
        for (int ai = 0; ai < 2; ++ai)
#pragma unroll
            for (int m = 0; m < 4; ++m) rsv[ai][m] = rsl[ai * HALF + wr * 64 + m * 16 + fr];
#pragma unroll
        for (int ai = 0; ai < 2; ++ai)
#pragma unroll
            for (int m = 0; m < 4; ++m) {
                const int row = row0 + ai * HALF + m * 16; const float rs = rsv[ai][m], nl = -1.4426950409f * rs, rs2 = rs * rs;
                float h[8];
#pragma unroll
                for (int n = 0; n < 2; ++n)
#pragma unroll
                    for (int j = 0; j < 4; ++j) { const float g = acc[ai][0][m][n][j], uu = acc[ai][1][m][n][j];
                        h[n * 4 + j] = (g * uu) * (rs2 * fast_rcp(1.f + __builtin_amdgcn_exp2f(g * nl))); }
                u32x4 w; w.x = cvt_pk_bf16(h[0], h[1]); w.y = cvt_pk_bf16(h[2], h[3]); w.z = cvt_pk_bf16(h[4], h[5]); w.w = cvt_pk_bf16(h[6], h[7]);
                st16_wt(ACT + (size_t)row * DFF + col0, w);
            }
    }
};
struct EpiResid {
    float* X; bf16_t* XB; float* ssn; float scale; float* PART;
    __device__ __forceinline__ void prefetch(f32x4 (&)[4], const Unit&, int) const {}
    __device__ __forceinline__ void operator()(const f32x4 (&acc)[2][2][4][2], const Unit& u, int wr, int wc, int fr, int fq, const f32x4 (&pf)[4]) const {
        const int row0 = u.pm * 256 + wr * 64 + fr, col0 = u.pn * 256 + wc * 32 + 8 * fq;
        if (u.kc >= 0) {
#pragma unroll
            for (int ai = 0; ai < 2; ++ai)
#pragma unroll
                for (int m = 0; m < 4; ++m) {
                    const int row = row0 + ai * HALF + m * 16 - MP;
#pragma unroll
                    for (int bj = 0; bj < 2; ++bj) { float* pp = PART + ((size_t)u.kc * MS + row) * D + col0 + bj * HALF; *(GAS f32x4*)pp = acc[ai][bj][m][0]; *(GAS f32x4*)(pp + 4) = acc[ai][bj][m][1]; }
                }
            return;
        }
        u32x4 oldx[2][4][2];
#pragma unroll
        for (int ai = 0; ai < 2; ++ai)
#pragma unroll
            for (int m = 0; m < 4; ++m)
#pragma unroll
                for (int bj = 0; bj < 2; ++bj) oldx[ai][m][bj] = *(const GAS u32x4*)(XB + (size_t)(row0 + ai * HALF + m * 16) * D + col0 + bj * HALF);
#pragma unroll
        for (int ai = 0; ai < 2; ++ai)
#pragma unroll
            for (int m = 0; m < 4; ++m) {
                const int row = row0 + ai * HALF + m * 16; float s = 0.f;
#pragma unroll
                for (int bj = 0; bj < 2; ++bj) {
                    bf16_t* xp = XB + (size_t)row * D + col0 + bj * HALF;
                    const u32x4 o = oldx[ai][m][bj];
                    f32x4 a = (f32x4){bf_lo(o.x), bf_hi(o.x), bf_lo(o.y), bf_hi(o.y)}, b = (f32x4){bf_lo(o.z), bf_hi(o.z), bf_lo(o.w), bf_hi(o.w)};
                    a = a + acc[ai][bj][m][0] * scale; b = b + acc[ai][bj][m][1] * scale;
                    u32x4 w; w.x = cvt_pk_bf16(a.x, a.y); w.y = cvt_pk_bf16(a.z, a.w); w.z = cvt_pk_bf16(b.x, b.y); w.w = cvt_pk_bf16(b.z, b.w);
                    st16_wt(xp, w);
                    s += (a.x * a.x + a.y * a.y) + (a.z * a.z + a.w * a.w) + (b.x * b.x + b.y * b.y) + (b.z * b.z + b.w * b.w);
                }
                s += __shfl_xor(s, 16); s += __shfl_xor(s, 32);
                if (fq == 0) *(GAS float*)(ssn + (size_t)row * 16 + u.pn * 4 + wc) = s;
            }
    }
};
struct EpiRgIn {
    bf16_t* GG; bf16_t* XR; const float* ss; LAS float* rsl;
    __device__ __forceinline__ void prefetch(f32x4 (&pf)[4], const Unit& u, int tid) const { rstd_prefetch(pf, ss, u.pm, tid); }
    __device__ __forceinline__ void operator()(const f32x4 (&acc)[2][2][4][2], const Unit& u, int wr, int wc, int fr, int fq, const f32x4 (&pf)[4]) const {
        const int row0 = u.pm * 256 + wr * 64 + fr, col0 = (u.pn & 3) * 256 + wc * 32 + 8 * fq;
        const bool is_gate = u.pn < 4;
        unit_rstd(pf, rsl, (wr * 4 + wc) * 64 + fq * 16 + fr);
#pragma unroll
        for (int ai = 0; ai < 2; ++ai)
#pragma unroll
            for (int m = 0; m < 4; ++m) {
                const int row = row0 + ai * HALF + m * 16; const float rs = rsl[ai * HALF + wr * 64 + m * 16 + fr];
#pragma unroll
                for (int bj = 0; bj < 2; ++bj) {
                    const f32x4 a = acc[ai][bj][m][0] * rs, b = acc[ai][bj][m][1] * rs;
                    const size_t off = (size_t)row * D + col0 + bj * HALF;
                    if (is_gate) {
                        u32x4 w; w.x = cvt_pk_bf16(gelu_tanh_(a.x), gelu_tanh_(a.y)); w.y = cvt_pk_bf16(gelu_tanh_(a.z), gelu_tanh_(a.w));
                        w.z = cvt_pk_bf16(gelu_tanh_(b.x), gelu_tanh_(b.y)); w.w = cvt_pk_bf16(gelu_tanh_(b.z), gelu_tanh_(b.w));
                        *(GAS u32x4*)(GG + off) = w;
                    } else { u32x4 w; w.x = cvt_pk_bf16(a.x, a.y); w.y = cvt_pk_bf16(a.z, a.w); w.z = cvt_pk_bf16(b.x, b.y); w.w = cvt_pk_bf16(b.z, b.w); *(GAS u32x4*)(XR + off) = w; }
                }
            }
    }
};
struct EpiGates {
    unsigned char* MIXp; const float* tab;
    __device__ __forceinline__ void prefetch(f32x4 (&)[4], const Unit&, int) const {}
    __device__ __forceinline__ void operator()(const f32x4 (&acc)[2][2][4][2], const Unit& u, int wr, int wc, int fr, int fq, const f32x4 (&pf)[4]) const {
        const int row0 = u.pm * 256 + wr * 64 + fr, ch0 = (u.pn >> 1) * 256 + (u.pn & 1) * 128 + wc * 32 + 8 * fq;
        u32x4 xcw[2][4]; f32x4 ba[2], bx[2], sp[2];
#pragma unroll
        for (int ai = 0; ai < 2; ++ai)
#pragma unroll
            for (int m = 0; m < 4; ++m) xcw[ai][m] = *(const GAS u32x4*)((const bf16_t*)(MIXp + MIX_XC) + (size_t)(row0 + ai * HALF + m * 16) * D + ch0);
#pragma unroll
        for (int n = 0; n < 2; ++n) { ba[n] = *(const GAS f32x4*)(tab + ch0 + 4 * n); bx[n] = *(const GAS f32x4*)(tab + D + ch0 + 4 * n); sp[n] = *(const GAS f32x4*)(tab + 2 * D + ch0 + 4 * n); }
#pragma unroll
        for (int ai = 0; ai < 2; ++ai)
#pragma unroll
            for (int m = 0; m < 4; ++m) {
                const int row = row0 + ai * HALF + m * 16; const size_t off = (size_t)row * D + ch0;
                const u32x4 xw = xcw[ai][m];
                const float xc[8] = {bf_lo(xw.x), bf_hi(xw.x), bf_lo(xw.y), bf_hi(xw.y), bf_lo(xw.z), bf_hi(xw.z), bf_lo(xw.w), bf_hi(xw.w)};
                h16x8 la8, u8;
#pragma unroll
                for (int n = 0; n < 2; ++n) {
#pragma unroll
                    for (int jx = 0; jx < 4; ++jx) {
                        const float r = sigmoidf_(acc[ai][0][m][n][jx] + ba[n][jx]), ig = sigmoidf_(acc[ai][1][m][n][jx] + bx[n][jx]);
                        const float la = r * sp[n][jx], x2 = 2.f * la;
                        const float om = (x2 > -0.03f) ? -x2 * (1.f + x2 * (0.5f + x2 * (0.16666667f + x2 * 0.041666668f))) : 1.f - __expf(x2);
                        const float uu = __builtin_amdgcn_sqrtf(fmaxf(om, 0.f)) * (ig * xc[n * 4 + jx]);
                        la8[n * 4 + jx] = (_Float16)la; u8[n * 4 + jx] = (_Float16)uu;
                    }
                }
                { union { h16x8 h; u32x4 u; } c0, c1; c0.h = la8; c1.h = u8; st16_wt((_Float16*)(MIXp + MIX_XR) + off, c0.u); st16_wt((_Float16*)(MIXp + MIX_U) + off, c1.u); }
            }
    }
};
struct EpiQ {
    bf16_t* Q; const float* ss; LAS float* rsl;
    __device__ __forceinline__ void prefetch(f32x4 (&pf)[4], const Unit& u, int tid) const { rstd_prefetch(pf, ss, u.pm, tid); }
    __device__ __forceinline__ void operator()(const f32x4 (&acc)[2][2][4][2], const Unit& u, int wr, int wc, int fr, int fq, const f32x4 (&pf)[4]) const {
        const int row0 = u.pm * 256 + wr * 64 + fr, col0 = u.pn * 256 + wc * 32 + 8 * fq;
        unit_rstd(pf, rsl, (wr * 4 + wc) * 64 + fq * 16 + fr);
        float rsv[2][4];
#pragma unroll
        for (int ai = 0; ai < 2; ++ai)
#pragma unroll
            for (int m = 0; m < 4; ++m) rsv[ai][m] = rsl[ai * HALF + wr * 64 + m * 16 + fr];
#pragma unroll
        for (int ai = 0; ai < 2; ++ai)
#pragma unroll
            for (int m = 0; m < 4; ++m) {
                const int row = row0 + ai * HALF + m * 16; const float rs = rsv[ai][m];
#pragma unroll
                for (int bj = 0; bj < 2; ++bj) {
                    const f32x4 a = acc[ai][bj][m][0] * rs, b = acc[ai][bj][m][1] * rs;
                    u32x4 w; w.x = cvt_pk_bf16(a.x, a.y); w.y = cvt_pk_bf16(a.z, a.w); w.z = cvt_pk_bf16(b.x, b.y); w.w = cvt_pk_bf16(b.z, b.w);
                    st16_wt(Q + (size_t)row * D + col0 + bj * HALF, w);
                }
            }
    }
};
struct EpiKV {
    bf16_t* KVB; float* out; const float* ss; LAS float* rsl;
    __device__ __forceinline__ void prefetch(f32x4 (&pf)[4], const Unit& u, int tid) const { rstd_prefetch(pf, ss, u.pm, tid); }
    __device__ __forceinline__ void operator()(const f32x4 (&acc)[2][2][4][2], const Unit& u, int wr, int wc, int fr, int fq, const f32x4 (&pf)[4]) const {
        const int row0 = u.pm * 256 + wr * 64 + fr, col0 = wc * 32 + 8 * fq;
        unit_rstd(pf, rsl, (wr * 4 + wc) * 64 + fq * 16 + fr);
#pragma unroll
        for (int ai = 0; ai < 2; ++ai)
#pragma unroll
            for (int m = 0; m < 4; ++m) {
                const int row = row0 + ai * HALF + m * 16; const float rs = rsl[ai * HALF + wr * 64 + m * 16 + fr];
                long obase = -1;
                size_t okoff = O_PK, ovoff = O_PV;
                if (row < MP) { const int b = row >> 12, t = row & 4095; if (t >= SEQ - 128) obase = ((long)b * 128 + (t - (SEQ - 128))) * 128; }
                else { const int s = (row - MP) >> 3, i = (row - MP) & 7; obase = ((long)s * 128 + 120 + i) * 128; okoff = O_SK; ovoff = O_SV; }
#pragma unroll
                for (int bj = 0; bj < 2; ++bj) {
                    const f32x4 a = acc[ai][bj][m][0] * rs, b = acc[ai][bj][m][1] * rs;
                    u32x4 w; w.x = cvt_pk_bf16(a.x, a.y); w.y = cvt_pk_bf16(a.z, a.w); w.z = cvt_pk_bf16(b.x, b.y); w.w = cvt_pk_bf16(b.z, b.w);
                    *(GAS u32x4*)(KVB + (size_t)row * 256 + bj * HALF + col0) = w;
                    if (obase >= 0) { float* o = out + (bj ? ovoff : okoff) + obase + col0; *(GAS f32x4*)o = a; *(GAS f32x4*)(o + 4) = b; }
                }
            }
    }
};

__device__ __forceinline__ void prep_macro(const float* s0, const float* s1, const float* s2, const float* s3, int ldsrc, int k0, const float* gain, float cs, bf16_t* dst, int ldd, int n0, LAS float* scr, int tid) {
    const float* srcq[4] = {s0, s1, s2, s3};
    f32x4 v[4][2];
#pragma unroll
    for (int q = 0; q < 4; ++q)
#pragma unroll
        for (int i = 0; i < 2; ++i) { const int kk = (tid >> 4) + 32 * i, cc = (tid & 15) * 4; v[q][i] = *(const GAS f32x4*)(srcq[q] + (size_t)(k0 + kk) * ldsrc + cc); }
    float g[2];
#pragma unroll
    for (int i = 0; i < 2; ++i) g[i] = gain ? cs * gain[k0 + (tid >> 4) + 32 * i] : cs;
#pragma unroll
    for (int q = 0; q < 4; ++q)
#pragma unroll
        for (int i = 0; i < 2; ++i) { const int kk = (tid >> 4) + 32 * i, cc = (tid & 15) * 4; LAS float* s = scr + q * 4160 + kk * 65 + cc;
            s[0] = v[q][i].x * g[i]; s[1] = v[q][i].y * g[i]; s[2] = v[q][i].z * g[i]; s[3] = v[q][i].w * g[i]; }
    __syncthreads();
    const int n = tid >> 3, c = tid & 7;
#pragma unroll
    for (int q = 0; q < 4; ++q) { const LAS float* s = scr + q * 4160 + (8 * c) * 65 + n;
        u32x4 o; o.x = cvt_pk_bf16(s[0], s[65]); o.y = cvt_pk_bf16(s[130], s[195]); o.z = cvt_pk_bf16(s[260], s[325]); o.w = cvt_pk_bf16(s[390], s[455]);
        *(GAS u32x4*)(dst + (size_t)(n0 + 64 * q + n) * ldd + k0 + 8 * c) = o; }
    __syncthreads();
}
__device__ __forceinline__ void prep_plain(const float* src, int ldsrc, int kt, int nt4, const float* gain, float cs, bf16_t* dst, int ldd, LAS float* scr, int tid) {
    const float* b = src + 256 * nt4; prep_macro(b, b + 64, b + 128, b + 192, ldsrc, kt * 64, gain, cs, dst, ldd, 256 * nt4, scr, tid);
}

__device__ __forceinline__ void phase_prep(const Params& P, LAS unsigned char* lds, int wv) {
    const int tid = opaque_tid(wv), lane = tid & 63, wave = tid >> 6, G = opaque_s((int)gridDim.x), bid = opaque_s((int)blockIdx.x);
    LAS float* scr = (LAS float*)lds;
    bf16_t* W = (bf16_t*)(P.ws + WS_W);
    constexpr int I_GU = 8 * 352, I_D = I_GU + 8 * 176, I_IN = I_D + 2 * 128, I_OUT = I_IN + 2 * 64, I_KV = I_OUT + 16, I_Q = I_KV + 2 * 64, I_O = I_Q + 2 * 64, I_G = I_O + 2 * 32;
    for (int it = bid; it < I_G; it += G) {
        if (it < I_GU) { const int j = it / 352, r = it % 352, l = j >> 1, f = j & 1, kt = r & 15, pn = r >> 4;
            const float* b = P.in[f ? 11 : 7] + (size_t)l * D * NGU + 128 * pn;
            prep_macro(b, b + 64, b + DFF, b + DFF + 64, NGU, kt * 64, P.in[f ? 10 : 6] + l * D, 1.f, W + W_GU + (size_t)j * NGU * D, D, 256 * pn, scr, tid);
        } else if (it < I_D) { const int q = it - I_GU, j = q / 176, r = q % 176, l = j >> 1, f = j & 1, kt = r % 44, nt4 = r / 44;
            prep_plain(P.in[f ? 12 : 8] + (size_t)l * DFF * D, D, kt, nt4, nullptr, 1.f, W + W_D + (size_t)j * D * DFF, DFF, scr, tid);
        } else if (it < I_IN) { const int q = it - I_D, l = q / 128, r = q % 128, kt = r & 15, nt4 = r >> 4;
            prep_plain(P.in[13] + (size_t)l * D * 2048, 2048, kt, nt4, P.in[9] + l * D, 1.f, W + W_IN + (size_t)l * 2048 * D, D, scr, tid);
        } else if (it < I_OUT) { const int q = it - I_IN, l = q / 64, r = q % 64, kt = r & 15, nt4 = r >> 4;
            prep_plain(P.in[21] + (size_t)l * D * D, D, kt, nt4, nullptr, 1.f, W + W_OUT + (size_t)l * D * D, D, scr, tid);
        } else if (it < I_KV) { const int r = it - I_OUT, kt = r & 15;
            prep_plain(P.in[23], 256, kt, 0, P.in[22], 1.f, W + W_KV, D, scr, tid);
        } else if (it < I_Q) { const int q = it - I_KV, l = q / 64, r = q % 64, kt = r & 15, nt4 = r >> 4;
            prep_plain(P.in[24] + (size_t)l * D * D, D, kt, nt4, P.in[9] + (2 + l) * D, 0.125f, W + W_Q + (size_t)l * D * D, D, scr, tid);
        } else if (it < I_O) { const int q = it - I_Q, l = q / 64, r = q % 64, kt = r & 15, nt4 = r >> 4;
            prep_plain(P.in[26] + (size_t)l * D * D, D, kt, nt4, nullptr, 1.f, W + W_O + (size_t)l * D * D, D, scr, tid);
        } else { const int q = it - I_O, l = q / 32, r = q % 32, kt = r & 3, pn = r >> 2, nb = pn >> 1, hh = pn & 1;
            const float* a = P.in[16] + (size_t)l * 4 * 65536 + (size_t)nb * 65536 + hh * 128; const float* x = P.in[18] + (size_t)l * 4 * 65536 + (size_t)nb * 65536 + hh * 128;
            prep_macro(a, a + 64, x, x + 64, 256, kt * 64, nullptr, 1.f, W + W_G + (size_t)l * 2048 * 256, 256, 256 * pn, scr, tid);
        }
    }
    float* X = P.out + O_X; bf16_t* XB = (bf16_t*)(P.ws + WS_XB); float* SS = (float*)(P.ws + WS_SSP);
    const int gw = bid * 8 + wave, NGW = G * 8;
    for (int row = gw; row < M; row += 2 * NGW) {
        const int row2 = row + NGW; const bool has2 = row2 < M; const int r2 = has2 ? row2 : row;
        const float* src = row < MP ? P.in[0] + (size_t)row * D : P.in[1] + (size_t)(row - MP) * D;
        const float* src2 = r2 < MP ? P.in[0] + (size_t)r2 * D : P.in[1] + (size_t)(r2 - MP) * D;
        f32x4 v[4], v2[4];
#pragma unroll
        for (int j = 0; j < 4; ++j) { v[j] = *(const GAS f32x4*)(src + j * 256 + lane * 4); v2[j] = *(const GAS f32x4*)(src2 + j * 256 + lane * 4); }
        float s = 0.f, s2 = 0.f;
#pragma unroll
        for (int j = 0; j < 4; ++j) {
            u32x2 w; w.x = cvt_pk_bf16(v[j].x, v[j].y); w.y = cvt_pk_bf16(v[j].z, v[j].w);
            *(GAS u32x2*)(XB + (size_t)row * D + j * 256 + lane * 4) = w;
            const f32x4 q = (f32x4){bf_lo(w.x), bf_hi(w.x), bf_lo(w.y), bf_hi(w.y)};
            s += (q.x * q.x + q.y * q.y) + (q.z * q.z + q.w * q.w);
            u32x2 w2; w2.x = cvt_pk_bf16(v2[j].x, v2[j].y); w2.y = cvt_pk_bf16(v2[j].z, v2[j].w);
            if (has2) *(GAS u32x2*)(XB + (size_t)row2 * D + j * 256 + lane * 4) = w2;
            const f32x4 q2 = (f32x4){bf_lo(w2.x), bf_hi(w2.x), bf_lo(w2.y), bf_hi(w2.y)};
            s2 += (q2.x * q2.x + q2.y * q2.y) + (q2.z * q2.z + q2.w * q2.w);
        }
#pragma unroll
        for (int o = 1; o < 64; o <<= 1) { s += __shfl_xor(s, o); s2 += __shfl_xor(s2, o); }
        if (lane < 16) { SS[(size_t)row * 16 + lane] = lane == 0 ? s : 0.f; if (has2) SS[(size_t)row2 * 16 + lane] = lane == 0 ? s2 : 0.f; }
    }
    const int gt = bid * NTHR + tid, NGT = G * NTHR;
    if (gt < 2 * D) { const int l = gt >> 10, c = gt & 1023; const float z = -P.in[20][gt]; float* tab = (float*)(P.ws + WS_SPT) + l * 3 * D;
        tab[c] = P.in[17][gt]; tab[D + c] = P.in[19][gt]; tab[2 * D + c] = -8.0f * (fmaxf(z, 0.f) + log1pf(expf(-fabsf(z)))); }
    bf16_t* CKB = (bf16_t*)(P.ws + WS_CKB);
    for (int i = gt; i < 2 * DB * 4096; i += NGT) {
        const int which = i / (DB * 4096), r = i % (DB * 4096), s = r / 4096, q = r % 4096;
        const f32x4 v = *(const GAS f32x4*)(P.in[4 + which] + (size_t)s * 16384 + q * 4);
        if (q >= 256) *(GAS f32x4*)(P.out + (which ? O_SV : O_SK) + (size_t)s * 16384 + (q - 256) * 4) = v;
        u32x2 w; w.x = cvt_pk_bf16(v.x, v.y); w.y = cvt_pk_bf16(v.z, v.w);
        *(GAS u32x2*)(CKB + (size_t)which * DB * 16384 + (size_t)s * 16384 + q * 4) = w;
    }
}

__device__ __forceinline__ void phase_conv(const Params& P, int l, int wv) {
    const int tid = opaque_tid(wv), rc = tid >> 7, c8 = (tid & 127) * 8;
    const bf16_t* XR = (const bf16_t*)(P.ws + WS_MIX + MIX_XR); bf16_t* XC = (bf16_t*)(P.ws + WS_MIX + MIX_XC);
    const float* cw = P.in[14] + (size_t)l * 4 * D; const float* cb = P.in[15] + (size_t)l * D;
    float w[4][8], bb[8];
#pragma unroll
    for (int k = 0; k < 4; ++k) { const f32x4 a = *(const GAS f32x4*)(cw + k * D + c8), b = *(const GAS f32x4*)(cw + k * D + c8 + 4);
        w[k][0] = a.x; w[k][1] = a.y; w[k][2] = a.z; w[k][3] = a.w; w[k][4] = b.x; w[k][5] = b.y; w[k][6] = b.z; w[k][7] = b.w; }
    { const f32x4 a = *(const GAS f32x4*)(cb + c8), b = *(const GAS f32x4*)(cb + c8 + 4); bb[0] = a.x; bb[1] = a.y; bb[2] = a.z; bb[3] = a.w; bb[4] = b.x; bb[5] = b.y; bb[6] = b.z; bb[7] = b.w; }
    for (int u = opaque_s((int)blockIdx.x); u < M / 32; u += opaque_s((int)gridDim.x)) {
        const int r0 = u * 32 + rc * 8;
        const bool samp = r0 >= MP; const int t0 = samp ? 0 : (r0 & 4095); const int sq = samp ? (r0 - MP) >> 3 : (r0 >> 12);
        float h[3][8];
#pragma unroll
        for (int k = 0; k < 3; ++k) {
            if (t0 > 0) { const u32x4 w = *(const GAS u32x4*)(XR + (size_t)(r0 - 3 + k) * D + c8);
                h[k][0] = bf_lo(w.x); h[k][1] = bf_hi(w.x); h[k][2] = bf_lo(w.y); h[k][3] = bf_hi(w.y); h[k][4] = bf_lo(w.z); h[k][5] = bf_hi(w.z); h[k][6] = bf_lo(w.w); h[k][7] = bf_hi(w.w); }
            else if (samp) { const float* src = P.in[3] + (((size_t)l * DB + sq) * 3 + k) * D + c8;
                const f32x4 a = *(const GAS f32x4*)src, b = *(const GAS f32x4*)(src + 4); h[k][0] = a.x; h[k][1] = a.y; h[k][2] = a.z; h[k][3] = a.w; h[k][4] = b.x; h[k][5] = b.y; h[k][6] = b.z; h[k][7] = b.w; }
            else {
#pragma unroll
                for (int e = 0; e < 8; ++e) h[k][e] = 0.f; }
        }
        const bool tail = samp || (t0 == SEQ - 8);
        float* so = P.out + (samp ? O_SC + (((size_t)l * DB + sq) * 3) * D : O_PC + (((size_t)l * NSEQ + sq) * 3) * D) + c8;
        u32x4 xrow[8];
#pragma unroll
        for (int i = 0; i < 8; ++i) xrow[i] = *(const GAS u32x4*)(XR + (size_t)(r0 + i) * D + c8);
#pragma unroll
        for (int i = 0; i < 8; ++i) {
            const u32x4 xw = xrow[i];
            const float cur[8] = {bf_lo(xw.x), bf_hi(xw.x), bf_lo(xw.y), bf_hi(xw.y), bf_lo(xw.z), bf_hi(xw.z), bf_lo(xw.w), bf_hi(xw.w)};
            const f32x4 a = (f32x4){cur[0], cur[1], cur[2], cur[3]}, b = (f32x4){cur[4], cur[5], cur[6], cur[7]};
            float y[8];
#pragma unroll
            for (int e = 0; e < 8; ++e) { y[e] = bb[e] + w[0][e] * h[0][e] + w[1][e] * h[1][e] + w[2][e] * h[2][e] + w[3][e] * cur[e]; h[0][e] = h[1][e]; h[1][e] = h[2][e]; h[2][e] = cur[e]; }
            u32x4 o; o.x = cvt_pk_bf16(y[0], y[1]); o.y = cvt_pk_bf16(y[2], y[3]); o.z = cvt_pk_bf16(y[4], y[5]); o.w = cvt_pk_bf16(y[6], y[7]);
            *(GAS u32x4*)(XC + (size_t)(r0 + i) * D + c8) = o;
            if (tail && i >= 5) { *(GAS f32x4*)(so + (size_t)(i - 5) * D) = a; *(GAS f32x4*)(so + (size_t)(i - 5) * D + 4) = b; }
        }
    }
}

__device__ __forceinline__ void phase_scan1(const Params& P, int wv) {
    const int tid = opaque_tid(wv), ch = tid * 2;
    const _Float16* LA = (const _Float16*)(P.ws + WS_MIX + MIX_XR); const _Float16* U = (const _Float16*)(P.ws + WS_MIX + MIX_U);
    float* CS = (float*)(P.ws + WS_CARRY); float* CH = CS + 256 * 1024;
    for (int u = opaque_s((int)blockIdx.x); u < 256; u += opaque_s((int)gridDim.x)) {
        const size_t base = (size_t)u * 64 * D + ch;
        float s0 = 0.f, s1 = 0.f, h0 = 0.f, h1 = 0.f;
#pragma unroll 8
        for (int t = 0; t < 64; ++t) {
            const h16x2 la = *(const GAS h16x2*)(LA + base + (size_t)t * D), uu = *(const GAS h16x2*)(U + base + (size_t)t * D);
            const float l0 = (float)la.x, l1 = (float)la.y;
            h0 = __expf(l0) * h0 + (float)uu.x; h1 = __expf(l1) * h1 + (float)uu.y; s0 += l0; s1 += l1;
        }
        *(GAS f32x2*)(CS + (size_t)u * D + ch) = (f32x2){s0, s1}; *(GAS f32x2*)(CH + (size_t)u * D + ch) = (f32x2){h0, h1};
    }
}
__device__ __forceinline__ void phase_scan3(const Params& P, int l, int wv) {
    const int tid = opaque_tid(wv), ch = tid * 2;
    const _Float16* LA = (const _Float16*)(P.ws + WS_MIX + MIX_XR); const _Float16* U = (const _Float16*)(P.ws + WS_MIX + MIX_U);
    const bf16_t* GG = (const bf16_t*)(P.ws + WS_MIX + MIX_GG); bf16_t* HG = (bf16_t*)(P.ws + WS_MIX + MIX_XC);
    const float* CS = (const float*)(P.ws + WS_CARRY); const float* CH = CS + 256 * 1024;
    for (int u = opaque_s((int)blockIdx.x); u < 256 + 16; u += opaque_s((int)gridDim.x)) {
        if (u < 256) {
            const int b = u >> 6, c = u & 63;
            float h0 = 0.f, h1 = 0.f;
#pragma unroll 8
            for (int cc = 0; cc < c; ++cc) {
                const f32x2 s = *(const GAS f32x2*)(CS + (size_t)(b * 64 + cc) * D + ch), hh = *(const GAS f32x2*)(CH + (size_t)(b * 64 + cc) * D + ch);
                h0 = __expf(s.x) * h0 + hh.x; h1 = __expf(s.y) * h1 + hh.y;
            }
            const size_t base = (size_t)u * 64 * D + ch;
#pragma unroll 1
            for (int tb = 0; tb < 64; tb += 8) {
                h16x2 la[8], uu[8]; unsigned g[8], hg[8];
#pragma unroll
                for (int t = 0; t < 8; ++t) { const size_t o = base + (size_t)(tb + t) * D; la[t] = *(const GAS h16x2*)(LA + o); uu[t] = *(const GAS h16x2*)(U + o); g[t] = *(const GAS unsigned*)(GG + o); }
#pragma unroll
                for (int t = 0; t < 8; ++t) { h0 = __expf((float)la[t].x) * h0 + (float)uu[t].x; h1 = __expf((float)la[t].y) * h1 + (float)uu[t].y; hg[t] = cvt_pk_bf16(h0 * bf_lo(g[t]), h1 * bf_hi(g[t])); }
#pragma unroll
                for (int t = 0; t < 8; ++t) *(GAS unsigned*)(HG + base + (size_t)(tb + t) * D) = hg[t];
            }
            if (c == 63) *(GAS f32x2*)(P.out + O_PH + ((size_t)l * NSEQ + b) * D + ch) = (f32x2){h0, h1};
        } else {
            const int v = u - 256;
            for (int q = 0; q < 8; ++q) {
                const int s = v * 8 + q;
                const f32x2 hi = *(const GAS f32x2*)(P.in[2] + ((size_t)l * DB + s) * D + ch);
                float h0 = hi.x, h1 = hi.y;
                const size_t base = (size_t)(MP + s * 8) * D + ch;
                h16x2 la[8], uu[8]; unsigned g[8], hg[8];
#pragma unroll
                for (int t = 0; t < 8; ++t) { const size_t o = base + (size_t)t * D; la[t] = *(const GAS h16x2*)(LA + o); uu[t] = *(const GAS h16x2*)(U + o); g[t] = *(const GAS unsigned*)(GG + o); }
#pragma unroll
                for (int t = 0; t < 8; ++t) { h0 = __expf((float)la[t].x) * h0 + (float)uu[t].x; h1 = __expf((float)la[t].y) * h1 + (float)uu[t].y; hg[t] = cvt_pk_bf16(h0 * bf_lo(g[t]), h1 * bf_hi(g[t])); }
#pragma unroll
                for (int t = 0; t < 8; ++t) *(GAS unsigned*)(HG + base + (size_t)t * D) = hg[t];
                *(GAS f32x2*)(P.out + O_SH + ((size_t)l * DB + s) * D + ch) = (f32x2){h0, h1};
            }
        }
    }
}

constexpr int KROW = 144;
constexpr int VROW = 560;
constexpr int KS_BYTES = 272 * KROW, VT_OFF = KS_BYTES;
__device__ __forceinline__ void attn_tile(LAS const unsigned char* Ks, LAS const unsigned char* Vt, int kt0, const bf16_t* qptr, bf16_t* optr,
                                          float slope, float sink, int diff0, int dmax, int lane) {
    const int j = lane & 15, g = lane >> 4;
    bf16x8 qf[2];
    qf[0] = *(const GAS bf16x8*)(qptr + g * 8); qf[1] = *(const GAS bf16x8*)(qptr + 32 + g * 8);
    f32x4 s[10];
#pragma unroll
    for (int kt = 0; kt < 10; ++kt) {
        f32x4 a = (f32x4){0.f, 0.f, 0.f, 0.f};
#pragma unroll
        for (int ks = 0; ks < 2; ++ks) {
            const bf16x8 kf = *(LAS const bf16x8*)(Ks + ((kt0 + kt) * 16 + j) * KROW + (ks * 32 + g * 8) * 2);
            a = __builtin_amdgcn_mfma_f32_16x16x32_bf16(kf, qf[ks], a, 0, 0, 0);
        }
        s[kt] = a;
        if (kt & 1) __builtin_amdgcn_sched_barrier(0);
    }
    float mx = sink;
#pragma unroll
    for (int kt = 0; kt < 10; ++kt)
#pragma unroll
        for (int r = 0; r < 4; ++r) {
            const int diff = diff0 - kt * 16 - r; const bool ok = (diff >= 0) && (diff <= dmax);
            const float v = ok ? s[kt][r] - slope * (float)diff : -1e30f; s[kt][r] = v; mx = fmaxf(mx, v);
        }
    mx = fmaxf(mx, __shfl_xor(mx, 16)); mx = fmaxf(mx, __shfl_xor(mx, 32));
    float sum = 0.f;
#pragma unroll
    for (int kt = 0; kt < 10; ++kt)
#pragma unroll
        for (int r = 0; r < 4; ++r) { const float p = __expf(s[kt][r] - mx); s[kt][r] = p; sum += p; }
    sum += __shfl_xor(sum, 16); sum += __shfl_xor(sum, 32);
    sum += __expf(sink - mx);
    const float inv = 1.f / sum;
    f32x4 o[4];
#pragma unroll
    for (int dt = 0; dt < 4; ++dt) o[dt] = (f32x4){0.f, 0.f, 0.f, 0.f};
#pragma unroll
    for (int kp = 0; kp < 5; ++kp) {
        union { u32x4 u; bf16x8 b; } pf;
        pf.u.x = cvt_pk_bf16(s[2 * kp][0], s[2 * kp][1]); pf.u.y = cvt_pk_bf16(s[2 * kp][2], s[2 * kp][3]);
        pf.u.z = cvt_pk_bf16(s[2 * kp + 1][0], s[2 * kp + 1][1]); pf.u.w = cvt_pk_bf16(s[2 * kp + 1][2], s[2 * kp + 1][3]);
#pragma unroll
        for (int dt = 0; dt < 4; ++dt) {
            LAS const unsigned char* vr = Vt + (dt * 16 + j) * VROW + ((kt0 + 2 * kp) * 16 + g * 4) * 2;
            const u32x2 lo = *(LAS const u32x2*)vr, hi = *(LAS const u32x2*)(vr + 32);
            union { u32x4 u; bf16x8 b; } vf; vf.u.x = lo.x; vf.u.y = lo.y; vf.u.z = hi.x; vf.u.w = hi.y;
            o[dt] = __builtin_amdgcn_mfma_f32_16x16x32_bf16(vf.b, pf.b, o[dt], 0, 0, 0);
        }
        __builtin_amdgcn_sched_barrier(0);
    }
#pragma unroll
    for (int dt = 0; dt < 4; ++dt) {
        u32x2 w; w.x = cvt_pk_bf16(o[dt].x * inv, o[dt].y * inv); w.y = cvt_pk_bf16(o[dt].z * inv, o[dt].w * inv);
        *(GAS u32x2*)(optr + dt * 16 + g * 4) = w;
    }
}

__device__ __forceinline__ void phase_attn(const Params& P, int j, LAS unsigned char* lds, int wv) {
    const int tid = opaque_tid(wv), lane = tid & 63, wave = __builtin_amdgcn_readfirstlane(tid >> 6);
    unsigned char* ws = opaque_p(P.ws);
    const bf16_t* KVB = (const bf16_t*)(ws + WS_KVB); const bf16_t* Q = (const bf16_t*)(ws + WS_MIX + MIX_GG); bf16_t* O = (bf16_t*)(ws + WS_MIX + MIX_XR);
    const float* sinks = opaque_p(opaque_p(P.in[25]) + opaque_s(j) * 16); const bf16_t* CKB = (const bf16_t*)(ws + WS_CKB);
    LAS unsigned char* Ks = lds; LAS unsigned char* Vt = lds + VT_OFF;
    for (int u = opaque_s((int)blockIdx.x); u < 512; u += opaque_s((int)gridDim.x)) {
        __syncthreads();
        if (u < 256) {
            const int b = u >> 6, qb = (u >> 1) & 31, kh = u & 1;
            const int pos0 = qb * 128 - 144;
#pragma unroll 2
            for (int idx = tid; idx < 272 * 8; idx += NTHR) {
                const int i = idx >> 3, c = idx & 7, pos = pos0 + i;
                u32x4 kv = (u32x4){0u, 0u, 0u, 0u}, vv = kv;
                if (pos >= 0) { const bf16_t* r = KVB + (size_t)(b * SEQ + pos) * 256 + kh * 64 + c * 8; kv = *(const GAS u32x4*)r; vv = *(const GAS u32x4*)(r + 128); }
                *(LAS u32x4*)(Ks + i * KROW + c * 16) = kv;
                LAS unsigned short* vt = (LAS unsigned short*)(Vt + (c * 8) * VROW + i * 2);
                vt[0 * (VROW / 2)] = (unsigned short)(vv.x & 0xffff); vt[1 * (VROW / 2)] = (unsigned short)(vv.x >> 16);
                vt[2 * (VROW / 2)] = (unsigned short)(vv.y & 0xffff); vt[3 * (VROW / 2)] = (unsigned short)(vv.y >> 16);
                vt[4 * (VROW / 2)] = (unsigned short)(vv.z & 0xffff); vt[5 * (VROW / 2)] = (unsigned short)(vv.z >> 16);
                vt[6 * (VROW / 2)] = (unsigned short)(vv.w & 0xffff); vt[7 * (VROW / 2)] = (unsigned short)(vv.w >> 16);
            }
            __syncthreads();
            const int h = kh * 8 + wave; const float slope = exp2f(-0.5f * (float)(h + 1)), sink = sinks[h];
            const int jq = lane & 15, g = lane >> 4;
#pragma unroll 1
            for (int qt = 0; qt < 8; ++qt) {
                const int q0 = qb * 128 + qt * 16, qpos = q0 + jq; const size_t row = (size_t)b * SEQ + qpos;
                attn_tile(Ks, Vt, qt, Q + row * D + h * 64, O + row * D + h * 64, slope, sink, 144 + jq - 4 * g, qpos < 127 ? qpos : 127, lane);
            }
        } else {
            const int v = u - 256, s = v >> 1, kh = v & 1;
#pragma unroll 1
            for (int idx = tid; idx < 160 * 8; idx += NTHR) {
                const int i = idx >> 3, c = idx & 7;
                u32x4 kv = (u32x4){0u, 0u, 0u, 0u}, vv = kv;
                if (i < 128) {
                    const bf16_t* kr = CKB + (((size_t)s * 128 + i) * 2 + kh) * 64 + c * 8;
                    kv = *(const GAS u32x4*)kr; vv = *(const GAS u32x4*)(kr + (size_t)DB * 16384);
                } else if (i < 136) { const bf16_t* r = KVB + (size_t)(MP + s * 8 + (i - 128)) * 256 + kh * 64 + c * 8; kv = *(const GAS u32x4*)r; vv = *(const GAS u32x4*)(r + 128); }
                *(LAS u32x4*)(Ks + i * KROW + c * 16) = kv;
                LAS unsigned short* vt = (LAS unsigned short*)(Vt + (c * 8) * VROW + i * 2);
                vt[0 * (VROW / 2)] = (unsigned short)(vv.x & 0xffff); vt[1 * (VROW / 2)] = (unsigned short)(vv.x >> 16);
                vt[2 * (VROW / 2)] = (unsigned short)(vv.y & 0xffff); vt[3 * (VROW / 2)] = (unsigned short)(vv.y >> 16);
                vt[4 * (VROW / 2)] = (unsigned short)(vv.z & 0xffff); vt[5 * (VROW / 2)] = (unsigned short)(vv.z >> 16);
                vt[6 * (VROW / 2)] = (unsigned short)(vv.w & 0xffff); vt[7 * (VROW / 2)] = (unsigned short)(vv.w >> 16);
            }
            __syncthreads();
            if (wave < 4) {
                const int jq = lane & 15, g = lane >> 4, h = kh * 8 + wave * 2 + (jq >> 3), i = jq & 7;
                const float slope = exp2f(-0.5f * (float)(h + 1)), sink = sinks[h];
                const size_t row = (size_t)MP + s * 8 + i;
                attn_tile(Ks, Vt, 0, Q + row * D + h * 64, O + row * D + h * 64, slope, sink, 128 + i - 4 * g, 127, lane);
            }
        }
    }
    __syncthreads();
}

constexpr size_t MIX_PART = 100663296;
__device__ __forceinline__ void phase_reduce(const Params& P, int nres_next, int wv) {
    const int tid = opaque_tid(wv), lane = tid & 63, wave = tid >> 6;
    unsigned char* ws = opaque_p(P.ws);
    float* X = opaque_p(P.out) + O_X; bf16_t* XB = (bf16_t*)(ws + WS_XB); float* SSn = (float*)(ws + WS_SSP) + (size_t)nres_next * M * 16;
    const float* PART = (const float*)(ws + WS_MIX + MIX_PART);
    for (int r = opaque_s((int)blockIdx.x) * 8 + wave; r < MS; r += opaque_s((int)gridDim.x) * 8) {
        const int row = MP + r; float s = 0.f;
        u32x2 o[4]; f32x4 a[4];
#pragma unroll
        for (int j = 0; j < 4; ++j) {
            const size_t c = (size_t)j * 256 + lane * 4;
            o[j] = *(const GAS u32x2*)(XB + (size_t)row * D + c);
            a[j] = *(const GAS f32x4*)(PART + (size_t)r * D + c);
#pragma unroll
            for (int kc = 1; kc < 6; ++kc) a[j] = a[j] + *(const GAS f32x4*)(PART + ((size_t)kc * MS + r) * D + c);
        }
#pragma unroll
        for (int j = 0; j < 4; ++j) {
            const size_t c = (size_t)j * 256 + lane * 4;
            f32x4 v = (f32x4){bf_lo(o[j].x), bf_hi(o[j].x), bf_lo(o[j].y), bf_hi(o[j].y)}; v = v + a[j] * 0.5f;
            u32x2 w; w.x = cvt_pk_bf16(v.x, v.y); w.y = cvt_pk_bf16(v.z, v.w);
            *(GAS u32x2*)(XB + (size_t)row * D + c) = w;
            v = (f32x4){bf_lo(w.x), bf_hi(w.x), bf_lo(w.y), bf_hi(w.y)};
            s += (v.x * v.x + v.y * v.y) + (v.z * v.z + v.w * v.w);
        }
#pragma unroll
        for (int o2 = 1; o2 < 64; o2 <<= 1) s += __shfl_xor(s, o2);
        if (lane < 16) SSn[(size_t)row * 16 + lane] = lane == 0 ? s : 0.f;
    }
}

__device__ __forceinline__ void phase_final(const Params& P, int wv) {
    const int tid = opaque_tid(wv), lane = tid & 63, wave = tid >> 6;
    float* X = P.out + O_X; const bf16_t* XB = (const bf16_t*)(P.ws + WS_XB); const float* ss = (const float*)(P.ws + WS_SSP) + 12 * (size_t)M * 16; const float* g = P.in[27];
    f32x4 gv[4];
#pragma unroll
    for (int j = 0; j < 4; ++j) gv[j] = *(const GAS f32x4*)(g + j * 256 + lane * 4);
    const int nwv = opaque_s((int)gridDim.x) * 8;
    for (int row = opaque_s((int)blockIdx.x) * 8 + wave; row < M; row += 2 * nwv) {
        const int row2 = row + nwv; const bool has2 = row2 < M; const int r2 = has2 ? row2 : row;
        const float rs = rstd_of(ss, row), rs2 = rstd_of(ss, r2);
        u32x2 o[4], o2[4];
#pragma unroll
        for (int j = 0; j < 4; ++j) { o[j] = *(const GAS u32x2*)(XB + (size_t)row * D + j * 256 + lane * 4); o2[j] = *(const GAS u32x2*)(XB + (size_t)r2 * D + j * 256 + lane * 4); }
#pragma unroll
        for (int j = 0; j < 4; ++j) {
            const f32x4 v = (f32x4){bf_lo(o[j].x), bf_hi(o[j].x), bf_lo(o[j].y), bf_hi(o[j].y)}; *(GAS f32x4*)(X + (size_t)row * D + j * 256 + lane * 4) = v * rs * gv[j];
            if (has2) { const f32x4 v2 = (f32x4){bf_lo(o2[j].x), bf_hi(o2[j].x), bf_lo(o2[j].y), bf_hi(o2[j].y)}; *(GAS f32x4*)(X + (size_t)row2 * D + j * 256 + lane * 4) = v2 * rs2 * gv[j]; }
        }
    }
}

#define XB_TMO      128
#define XB_XCNT(j)  (256  + 64 * (j))
#define XB_XSUB(j)  (1280 + 64 * (j))
#define XB_XGEN(j)  (2304 + 64 * (j))
#define XB_TOP      3328
#define XB_TOPGEN   3392
#define XCD_BAR_WORDS 3456
#define XB_SPIN_CAP (1u << 20)
__device__ __forceinline__ unsigned xb_ld(unsigned* p)              { return __hip_atomic_load(p, __ATOMIC_RELAXED, __HIP_MEMORY_SCOPE_AGENT); }
__device__ __forceinline__ unsigned xb_add(unsigned* p, unsigned v) { return __hip_atomic_fetch_add(p, v, __ATOMIC_RELAXED, __HIP_MEMORY_SCOPE_AGENT); }
__device__ __forceinline__ unsigned xb_xcc_id() { return (unsigned)__builtin_amdgcn_s_getreg((3 << 11) | 20) & 0xFu; }
#define XB_SPIN(cond, bar) do { unsigned _sp = 0; while (cond) { __builtin_amdgcn_s_sleep(1); \
    if ((++_sp & 255u) == 0u) { if (xb_ld(&(bar)[XB_TMO])) break; if (_sp > XB_SPIN_CAP) { atomicAdd(&(bar)[XB_TMO], 1u); break; } } } } while (0)
struct XcdBarrier { unsigned* bar; unsigned x; volatile LAS unsigned* st; };
__device__ __forceinline__ XcdBarrier xcd_barrier_post(unsigned* bar, volatile LAS unsigned* st) {
    XcdBarrier b; b.bar = bar; b.x = xb_xcc_id(); b.st = st;
    if (threadIdx.x == 0) (void)xb_add(&bar[XB_XCNT(b.x)], 1u);
    return b;
}
__device__ __forceinline__ void xcd_barrier_complete(unsigned* bar, unsigned x, unsigned& nloc, unsigned& nx) {
    const unsigned G = gridDim.x * gridDim.y * gridDim.z;
    unsigned sum, cnt, mine, sp = 0u;
    for (;;) {
        sum = 0u; cnt = 0u; mine = 0u;
#pragma unroll
        for (unsigned j = 0; j < 16; ++j) { const unsigned c = xb_ld(&bar[XB_XCNT(j)]); sum += c; cnt += (c > 0u) ? 1u : 0u; mine = (j == x) ? c : mine; }
        if (sum == G) break;
        __builtin_amdgcn_s_sleep(1);
        if ((++sp & 255u) == 0u) { if (xb_ld(&bar[XB_TMO])) break; if (sp > XB_SPIN_CAP) { atomicAdd(&bar[XB_TMO], 1u); break; } }
    }
    nloc = mine > 0u ? mine : 1u; nx = cnt > 0u ? cnt : 1u;
}
__device__ __forceinline__ void xcd_barrier(unsigned* bar, unsigned x, volatile LAS unsigned* st, int wv, bool wb) {
    asm volatile("s_waitcnt vmcnt(0)" ::: "memory");
    __syncthreads();
    if (opaque_tid(wv) == 0) {
        __builtin_amdgcn_s_waitcnt(0);
        unsigned nloc = st[0], nx = st[1];
        if (nloc == 0u) { xcd_barrier_complete(bar, x, nloc, nx); st[0] = nloc; st[1] = nx; }
        const unsigned old = xb_add(&bar[XB_XSUB(x)], 1u);
        const unsigned gen = old / nloc;
        if (old + 1u == (gen + 1u) * nloc) {
            if (wb) __builtin_amdgcn_fence(__ATOMIC_RELEASE, "agent");
            asm volatile("s_waitcnt vmcnt(0)" ::: "memory");
            asm volatile("buffer_inv sc1" ::: "memory");
            const unsigned og = xb_add(&bar[XB_TOP], 1u);
            const unsigned tg = og / nx;
            if (og + 1u == (tg + 1u) * nx) {
#pragma unroll
                for (unsigned j = 0; j < 16; ++j) xb_add(&bar[XB_XGEN(j)], 1u);
            } else XB_SPIN(xb_ld(&bar[XB_XGEN(x)]) == gen, bar);
            asm volatile("s_waitcnt vmcnt(0)" ::: "memory");
        } else {
            asm volatile("buffer_inv sc1" ::: "memory");
            XB_SPIN(xb_ld(&bar[XB_XGEN(x)]) == gen, bar);
            asm volatile("s_waitcnt vmcnt(0)" ::: "memory");
        }
    }
    __syncthreads();
}

constexpr int N_PHASES = 45;
constexpr int LDS_BYTES = 131072 + 64 + 1024;
__global__ void __launch_bounds__(NTHR, 2) yoco_fwd(Params P) {
    extern __shared__ __attribute__((aligned(16))) unsigned char lds_raw[];
    LAS unsigned char* lds = (LAS unsigned char*)lds_raw;
    cg::grid_group grid = cg::this_grid();
    const int wv = __builtin_amdgcn_readfirstlane((int)(threadIdx.x >> 6));
    int ph = 0, nres = 0;
    volatile LAS unsigned* bst = (volatile LAS unsigned*)(lds + 131072);
    if (threadIdx.x < 16) bst[threadIdx.x] = 0u;
    __syncthreads();
    unsigned* barw = (unsigned*)(P.ws + WS_BAR);
    const unsigned xcc = P.hi - P.lo > 1 ? xcd_barrier_post(barw, bst).x : 0u;
    if (P.hi > 100000) grid.sync();
#define ON() (ph >= P.lo && ph < P.hi)
#define PV() const int G = opaque_s((int)gridDim.x), bid = opaque_s((int)blockIdx.x); unsigned char* ws = opaque_p(P.ws); float* X = opaque_p(P.out); bf16_t* XB = (bf16_t*)(ws + WS_XB); float* SS = (float*)(ws + WS_SSP); \
    bf16_t* W = (bf16_t*)(ws + WS_W); unsigned char* MIX = ws + WS_MIX; (void)G; (void)bid; (void)X; (void)XB; (void)SS; (void)W; (void)MIX
#define SEAM_(wb) do { if (ph >= P.lo && ph + 1 < P.hi) xcd_barrier(opaque_p(barw), opaque_s((int)xcc), bst, wv, wb); ++ph; } while (0)
#define SEAM() SEAM_(true)

    if (ON()) phase_prep(P, lds, wv);
    SEAM();
    for (int l = 0; l < 4; ++l) {
        for (int f = 0; f < 2; ++f) {
            if (f == 1) {
                if (l < 2) {
                    if (ON()) { PV(); pg8::Gemm g{XB, W + W_IN + (size_t)l * 2048 * D, D, D, D, M / 256, 8, 0}; pg8::StaticOrder S; S.init(M / 256, 8, G, bid);
                        EpiRgIn E{(bf16_t*)(MIX + MIX_GG), (bf16_t*)(MIX + MIX_XR), SS + (size_t)nres * M * 16, (LAS float*)(lds + RS_OFF)}; pg8::gemm_phase(lds, g, S, E, wv); }
                    SEAM();
                    if (ON()) phase_conv(P, l, wv);
                    SEAM();
                    if (ON()) { PV(); pg8::Gemm g{(const bf16_t*)(MIX + MIX_XC), W + W_G + (size_t)l * 2048 * 256, D, 256, 256, M / 256, 8, 1}; pg8::StaticOrder S; S.init(M / 256, 8, G, bid);
                        EpiGates E{MIX, (const float*)(ws + WS_SPT) + l * 3 * D}; pg8::gemm_phase(lds, g, S, E, wv); }
                    SEAM_(false);
                    if (ON()) phase_scan1(P, wv);
                    SEAM();
                    if (ON()) phase_scan3(P, l, wv);
                    SEAM();
                    if (ON()) { PV(); pg8::Gemm g{(const bf16_t*)(MIX + MIX_XC), W + W_OUT + (size_t)l * D * D, D, D, D, M / 256, 4, 0}; pg8::StaticOrder S; S.init(M / 256, 4, G, bid);
                        EpiResid E{X, XB, SS + (size_t)(nres + 1) * M * 16, 1.f, nullptr}; pg8::gemm_phase(lds, g, S, E, wv); }
                    SEAM(); ++nres;
                } else {
                    const int j = opaque_s(opaque_s(l) - 2);
                    if (ON()) { PV(); pg8::Gemm g{XB, W + W_Q + (size_t)j * D * D, D, D, D, M / 256, 4, 0}; pg8::StaticOrder S; S.init(M / 256, 4, G, bid);
                        EpiQ E{(bf16_t*)(MIX + MIX_GG), SS + (size_t)nres * M * 16, (LAS float*)(lds + RS_OFF)}; pg8::gemm_phase(lds, g, S, E, wv); }
                    SEAM_(false);
                    if (ON()) phase_attn(P, j, lds, wv);
                    SEAM();
                    if (ON()) { PV(); pg8::Gemm g{(const bf16_t*)(MIX + MIX_XR), W + W_O + (size_t)j * D * D, D, D, D, M / 256, 4, 0}; pg8::StaticOrder S; S.init(M / 256, 4, G, bid);
                        EpiResid E{X, XB, SS + (size_t)(nres + 1) * M * 16, 1.f, nullptr}; pg8::gemm_phase(lds, g, S, E, wv); }
                    SEAM(); ++nres;
                }
            }
            if (ON()) { PV(); pg8::Gemm g{XB, W + W_GU + (size_t)(l * 2 + f) * NGU * D, D, D, D, M / 256, NGU / 256, 0}; pg8::StaticOrder S; S.init(M / 256, NGU / 256, G, bid);
                EpiSwiGLU E{(bf16_t*)(MIX + MIX_GG), SS + (size_t)nres * M * 16, (LAS float*)(lds + RS_OFF)}; pg8::gemm_phase(lds, g, S, E, wv); }
            SEAM_(false);
            if (ON()) { PV(); pg8::Gemm g{(const bf16_t*)(MIX + MIX_GG), W + W_D + (size_t)(l * 2 + f) * D * DFF, DFF, DFF, DFF, M / 256, 4, 0}; pg8::DownOrder S; S.init(G, bid);
                EpiResid E{X, XB, SS + (size_t)(nres + 1) * M * 16, 0.5f, (float*)(MIX + MIX_PART)}; pg8::gemm_phase(lds, g, S, E, wv); }
            SEAM();
            if (ON()) phase_reduce(P, nres + 1, wv);
            SEAM(); ++nres;
        }
        if (l == 1) {
            if (ON()) { PV(); pg8::Gemm g{XB, W + W_KV, D, D, D, M / 256, 1, 0}; pg8::StaticOrder S; S.init(M / 256, 1, G, bid);
                EpiKV E{(bf16_t*)(ws + WS_KVB), X, SS + (size_t)nres * M * 16, (LAS float*)(lds + RS_OFF)}; pg8::gemm_phase(lds, g, S, E, wv); }
            SEAM();
        }
    }
    if (ON()) phase_final(P, wv);
#undef ON
#undef SEAM
}

extern "C" void kernel_launch(void* const* d_in, const int* in_sizes, int n_in, void* d_out, int out_size, void* d_ws, size_t ws_size, hipStream_t stream) {
    static int grid = 0;
    if (grid == 0) {
        if (n_in != 28 || (size_t)out_size != OUT_TOTAL || ws_size < WS_END) { fprintf(stderr, "kernel_launch: unexpected shapes (n_in %d out %d ws %zu need %zu)\n", n_in, out_size, ws_size, (size_t)WS_END); grid = -1; return; }
        int dev = 0, cus = 0, per_cu = 0;
        hipGetDevice(&dev); hipDeviceGetAttribute(&cus, hipDeviceAttributeMultiprocessorCount, dev);
        if (hipFuncSetAttribute((const void*)yoco_fwd, hipFuncAttributeMaxDynamicSharedMemorySize, LDS_BYTES) != hipSuccess) { fprintf(stderr, "kernel_launch: hipFuncSetAttribute failed\n"); grid = -1; return; }
        hipOccupancyMaxActiveBlocksPerMultiprocessor(&per_cu, (const void*)yoco_fwd, NTHR, LDS_BYTES);
        (void)hipGetLastError();
        if (per_cu < 1) per_cu = 1;
        grid = cus;
        fprintf(stderr, "kernel_launch: cus %d per_cu %d grid %d\n", cus, per_cu, grid);
    }
    if (grid < 0) return;
    if (hipMemsetAsync((char*)d_ws + WS_BAR, 0, 16384, stream) != hipSuccess) { fprintf(stderr, "kernel_launch: memset failed\n"); return; }
    Params p{};
    for (int i = 0; i < 28; ++i) p.in[i] = (const float*)d_in[i];
    p.out = (float*)d_out; p.ws = (unsigned char*)d_ws;
#if N_LAUNCH_MODE == 1
#ifndef DBG_LAST_PHASE
#define DBG_LAST_PHASE (N_PHASES - 1)
#endif
    for (int i = 0; i < N_PHASES; ++i) { if (i > DBG_LAST_PHASE && i != N_PHASES - 1) continue; p.lo = i; p.hi = i + 1; hipLaunchKernelGGL(yoco_fwd, dim3(grid), dim3(NTHR), LDS_BYTES, stream, p); }
#else
    p.lo = 0; p.hi = N_PHASES;
    void* args[] = {&p};
    hipError_t e = hipLaunchCooperativeKernel((const void*)yoco_fwd, dim3(grid), dim3(NTHR), args, LDS_BYTES, stream);
    if (e != hipSuccess) fprintf(stderr, "cooperative launch failed: %s (grid %d)\n", hipGetErrorString(e), grid);
#endif
}
```
